# Optimizing an MI355X kernel written in HIP

```python
import jax, jax.numpy as jnp
from jax import lax
import numpy as np

D_MODEL = 1024
BATCH = 4
SEQ = 4096
DEPTH = 2

CTX_LEN = 256
GRID_W = 64
RMS_EPS = 1e-6
D_FF = 4 * D_MODEL

RW_HEADS = 8
RW_HEAD_DIM = 64
RW_WIDTH = RW_HEADS * RW_HEAD_DIM
RW_DECAY_RANK = 64
RW_ICLR_RANK = 64
RW_GATE_RANK = 128
RW_VRES_RANK = 32
RW_GN_EPS = 64e-5
RW_SPLIT = (RW_WIDTH, 2 * RW_WIDTH, 3 * RW_WIDTH,
            3 * RW_WIDTH + RW_DECAY_RANK,
            3 * RW_WIDTH + 2 * RW_DECAY_RANK,
            3 * RW_WIDTH + 2 * RW_DECAY_RANK + RW_ICLR_RANK,
            3 * RW_WIDTH + 2 * RW_DECAY_RANK + 2 * RW_ICLR_RANK)
RW_COLS = 3 * RW_WIDTH + 2 * RW_DECAY_RANK + 2 * RW_ICLR_RANK + RW_GATE_RANK

GLA_HEADS = 4
GLA_DK = 64
GLA_DV = 128
GLA_KW = GLA_HEADS * GLA_DK
GLA_VW = GLA_HEADS * GLA_DV
GLA_QKV_W = 2 * GLA_KW + GLA_VW
GLA_GATE_RANK = 16
GLA_TAU = 16.0
GLA_CHUNK = 64
GLA_SPLIT = (GLA_QKV_W, GLA_QKV_W + GLA_GATE_RANK, GLA_QKV_W + 2 * GLA_GATE_RANK)
GLA_COLS = GLA_QKV_W + 2 * GLA_GATE_RANK + GLA_VW

IN_SPLIT = (RW_COLS, RW_COLS + GLA_COLS)
IN_COLS = RW_COLS + GLA_COLS + 2 * D_MODEL

kernel_name = "hybrid_rwkv7_gla_dit_block"


def rms_norm(x, gain):
    xf = x.astype(jnp.float32)
    y = xf * lax.rsqrt(jnp.mean(xf * xf, axis=-1, keepdims=True) + RMS_EPS)
    return (y * gain).astype(x.dtype)


def modulate(x, gain, shift, scale):
    return rms_norm(x, gain) * (1.0 + scale) + shift


def shift_prev(t):
    return jnp.pad(t[:, :-1], ((0, 0), (1, 0), (0, 0)))


def shift_next(t):
    return jnp.pad(t[:, 1:], ((0, 0), (0, 1), (0, 0)))


def centred_conv3(t, w):
    return w[0] * shift_prev(t) + w[1] * t + w[2] * shift_next(t)


def to_scan_order(t, order, rows):
    if order == "row":
        return t
    b_, n_, f_ = t.shape
    return t.reshape(b_, rows, GRID_W, f_).transpose(0, 2, 1, 3).reshape(b_, n_, f_)


def from_scan_order(t, order, rows):
    if order == "row":
        return t
    b_, n_, f_ = t.shape
    return t.reshape(b_, GRID_W, rows, f_).transpose(0, 2, 1, 3).reshape(b_, n_, f_)


def rwkv7_scan(r, decay, k, v, kk, a, s0, reverse):
    def step(s, inp):
        r_t, w_t, k_t, v_t, kk_t, a_t = inp
        sa = jnp.einsum("bhvk,bhk->bhv", s, kk_t)
        s = (s * w_t[:, :, None, :]
             - sa[..., None] * (kk_t * a_t)[:, :, None, :]
             + v_t[..., None] * k_t[:, :, None, :])
        return s, jnp.einsum("bhvk,bhk->bhv", s, r_t)
    xs = tuple(jnp.moveaxis(t.astype(jnp.float32), 1, 0) for t in (r, decay, k, v, kk, a))
    s_final, ys = lax.scan(step, s0, xs, reverse=reverse)
    return jnp.moveaxis(ys, 0, 1), s_final


def rwkv7_branch(f, v_first, s0, lp):
    b_, t_, _ = f.shape
    heads = lambda t: t.reshape(b_, t_, RW_HEADS, RW_HEAD_DIM)
    f = f + lp["rw_mu"] * (0.5 * (shift_prev(f) + shift_next(f)) - f)
    r, k, v, wd_f, wd_b, ad_f, ad_b, gd = jnp.split(f, RW_SPLIT, axis=-1)
    if v_first is not None:
        v = v + (v_first - v) * jax.nn.sigmoid(
            lp["rw_vres_bias"] + (v @ lp["rw_vres_down"]) @ lp["rw_vres_up"])
    kk = heads(k * lp["rw_k_k"]).astype(jnp.float32)
    kk = kk * lax.rsqrt(jnp.sum(kk * kk, axis=-1, keepdims=True) + 1e-12)

    def direction(d, wd, ad, reverse):
        w = -jax.nn.softplus(-(lp["rw_w0"][d] + jnp.tanh(wd) @ lp["rw_w_up"][d])) - 0.5
        decay = jnp.exp(-jnp.exp(w.astype(jnp.float32)))
        a = jax.nn.sigmoid(lp["rw_a0"][d] + ad @ lp["rw_a_up"][d])
        k_rep = k * (1.0 + (a - 1.0) * lp["rw_k_a"])
        y, s = rwkv7_scan(heads(r), heads(decay), heads(k_rep), heads(v), kk, heads(a), s0[d], reverse)
        return y, s, k_rep

    y_f, s_f, k_f = direction(0, wd_f, ad_f, False)
    y_b, s_b, k_b = direction(1, wd_b, ad_b, True)
    y = y_f + y_b
    mean = jnp.mean(y, axis=-1, keepdims=True)
    var = jnp.mean(jnp.square(y - mean), axis=-1, keepdims=True)
    y = ((y - mean) * lax.rsqrt(var + RW_GN_EPS) * lp["rw_gn_w"].reshape(RW_HEADS, RW_HEAD_DIM)
         + lp["rw_gn_b"].reshape(RW_HEADS, RW_HEAD_DIM))
    bonus = jnp.sum(heads(r) * heads(k_f + k_b) * lp["rw_r_k"], axis=-1, keepdims=True) * heads(v)
    g = jax.nn.sigmoid(gd) @ lp["rw_g_up"]
    out = (y + bonus).reshape(b_, t_, RW_WIDTH) * g
    return out.astype(f.dtype), (s_f, s_b), v


def gla_chunked(q, k, v, log_alpha, s0):
    b_, t_, h_, _ = q.shape
    nc = t_ // GLA_CHUNK
    chunk = lambda t: t.reshape(b_, nc, GLA_CHUNK, h_, t.shape[-1])
    qc, kc, vc, gc = chunk(q), chunk(k), chunk(v), chunk(log_alpha)
    cum = jnp.cumsum(gc, axis=2)
    cum_last = cum[:, :, -1:]
    q_dec = qc * jnp.exp(cum)
    k_inv = kc * jnp.exp(-cum)
    k_to_end = kc * jnp.exp(cum_last - cum)
    causal = jnp.tril(jnp.ones((GLA_CHUNK, GLA_CHUNK), dtype=bool))
    scores = jnp.where(causal, jnp.einsum("bnthd,bnshd->bnhts", q_dec, k_inv), 0.0)
    o_intra = jnp.einsum("bnhts,bnshv->bnthv", scores, vc)
    chunk_kv = jnp.einsum("bnshd,bnshv->bnhdv", k_to_end, vc)
    chunk_decay = jnp.exp(cum_last[:, :, 0])

    def step(s, inp):
        dec, kv = inp
        return s * dec[..., None] + kv, s
    s_final, s_start = lax.scan(step, s0, (jnp.moveaxis(chunk_decay, 1, 0), jnp.moveaxis(chunk_kv, 1, 0)))
    o_inter = jnp.einsum("bnthd,bnhdv->bnthv", q_dec, jnp.moveaxis(s_start, 0, 1))
    return (o_intra + o_inter).reshape(b_, t_, h_, v.shape[-1]), s_final


def gla_branch(f, s0, lp):
    b_, t_, _ = f.shape
    qkv, ald_f, ald_b, gate = jnp.split(f, GLA_SPLIT, axis=-1)
    qkv = jax.nn.silu(centred_conv3(qkv, lp["gla_conv"]))
    q, k, v = jnp.split(qkv, (GLA_KW, 2 * GLA_KW), axis=-1)
    heads_k = lambda t: t.reshape(b_, t_, GLA_HEADS, GLA_DK).astype(jnp.float32)
    q = heads_k(q) * (GLA_DK ** -0.5)
    k = heads_k(k)
    v = v.reshape(b_, t_, GLA_HEADS, GLA_DV).astype(jnp.float32)
    log_alpha = lambda d, ad: heads_k(
        jax.nn.log_sigmoid(ad @ lp["gla_alpha_up"][d] + lp["gla_alpha_bias"][d])) / GLA_TAU
    flip = lambda t: t[:, ::-1]
    o_f, s_f = gla_chunked(q, k, v, log_alpha(0, ald_f), s0[0])
    o_b, s_b = gla_chunked(flip(q), flip(k), flip(v), flip(log_alpha(1, ald_b)), s0[1])
    o = o_f + flip(o_b)
    o = o * lax.rsqrt(jnp.mean(o * o, axis=-1, keepdims=True) + RMS_EPS) * lp["gla_norm_w"]
    out = o.reshape(b_, t_, GLA_VW) * jax.nn.silu(gate)
    return out.astype(f.dtype), (s_f, s_b)


def merge_branches(y_rw, y_gla, gate_cols, lp):
    g_rw, g_gla = jnp.split(jax.nn.sigmoid(gate_cols), 2, axis=-1)
    return (g_rw * (y_rw @ lp["rw_out"]) + g_gla * (y_gla @ lp["gla_out"])) @ lp["merge_out"]


def token_mixer(h_lat, h_ctx, v_first, lp, layer, rows, need_ctx_out):
    rw_order, gla_order = ("row", "col") if layer % 2 == 0 else ("col", "row")
    rw_lat, gla_lat, gate_lat = jnp.split(h_lat @ lp["w_in"], IN_SPLIT, axis=-1)
    rw_ctx, gla_ctx, gate_ctx = jnp.split(h_ctx @ lp["w_in"], IN_SPLIT, axis=-1)
    vf_lat, vf_ctx = v_first
    b_ = h_lat.shape[0]
    z_rw = jnp.zeros((b_, RW_HEADS, RW_HEAD_DIM, RW_HEAD_DIM), jnp.float32)
    z_gla = jnp.zeros((b_, GLA_HEADS, GLA_DK, GLA_DV), jnp.float32)
    y_rw_ctx, s_rw, v_ctx = rwkv7_branch(rw_ctx, vf_ctx, (z_rw, z_rw), lp)
    y_gla_ctx, s_gla = gla_branch(gla_ctx, (z_gla, z_gla), lp)
    vf_lat_o = None if vf_lat is None else to_scan_order(vf_lat, rw_order, rows)
    y_rw_lat, _, v_lat = rwkv7_branch(to_scan_order(rw_lat, rw_order, rows), vf_lat_o, s_rw, lp)
    y_rw_lat = from_scan_order(y_rw_lat, rw_order, rows)
    v_lat = from_scan_order(v_lat, rw_order, rows)
    y_gla_lat, _ = gla_branch(to_scan_order(gla_lat, gla_order, rows), s_gla, lp)
    y_gla_lat = from_scan_order(y_gla_lat, gla_order, rows)
    m_lat = merge_branches(y_rw_lat, y_gla_lat, gate_lat, lp)
    m_ctx = merge_branches(y_rw_ctx, y_gla_ctx, gate_ctx, lp) if need_ctx_out else None
    return m_lat, m_ctx, (v_lat, v_ctx)


def sq_relu_mlp(h, w1, w2):
    return jnp.square(jax.nn.relu(h @ w1)) @ w2


def setup_inputs(seed: int = 0) -> dict:
    key = jax.random.key(seed)
    ks = list(jax.random.split(key, 40))
    nrm = lambda shape, s: jax.random.normal(ks.pop(), shape, jnp.float32) * s
    uni = lambda shape, lo, hi: jax.random.uniform(ks.pop(), shape, jnp.float32, lo, hi)
    L, D = DEPTH, D_MODEL
    return {
        "x": nrm((BATCH, SEQ, D), 1.0),
        "c": nrm((BATCH, D), 1.0),
        "ctx": nrm((BATCH, CTX_LEN, D), 1.0),
        "c_ctx": nrm((D,), 1.0),
        "w_in": nrm((L, D, IN_COLS), D ** -0.5),
        "rw_mu": uni((L, RW_COLS), 0.0, 1.0),
        "rw_w0": uni((L, 2, RW_WIDTH), -6.0, 1.0),
        "rw_w_up": nrm((L, 2, RW_DECAY_RANK, RW_WIDTH), 0.1),
        "rw_a0": nrm((L, 2, RW_WIDTH), 0.3),
        "rw_a_up": nrm((L, 2, RW_ICLR_RANK, RW_WIDTH), 0.1),
        "rw_g_up": nrm((L, RW_GATE_RANK, RW_WIDTH), RW_GATE_RANK ** -0.5),
        "rw_k_k": 0.85 + nrm((L, RW_WIDTH), 0.05),
        "rw_k_a": 1.0 + nrm((L, RW_WIDTH), 0.05),
        "rw_r_k": nrm((L, RW_HEADS, RW_HEAD_DIM), 0.1),
        "rw_gn_w": 1.0 + nrm((L, RW_WIDTH), 0.02),
        "rw_gn_b": nrm((L, RW_WIDTH), 0.02),
        "rw_vres_down": nrm((L - 1, RW_WIDTH, RW_VRES_RANK), RW_WIDTH ** -0.5),
        "rw_vres_up": nrm((L - 1, RW_VRES_RANK, RW_WIDTH), RW_VRES_RANK ** -0.5),
        "rw_vres_bias": nrm((L - 1, RW_WIDTH), 0.1),
        "rw_out": nrm((L, RW_WIDTH, D), RW_WIDTH ** -0.5),
        "gla_conv": nrm((L, 3, GLA_QKV_W), 0.6),
        "gla_alpha_up": nrm((L, 2, GLA_GATE_RANK, GLA_KW), GLA_GATE_RANK ** -0.5),
        "gla_alpha_bias": uni((L, 2, GLA_KW), 0.0, 4.0),
        "gla_norm_w": 1.0 + nrm((L, GLA_DV), 0.02),
        "gla_out": nrm((L, GLA_VW, D), GLA_VW ** -0.5),
        "merge_out": nrm((L, D, D), D ** -0.5),
        "mlp_w1": nrm((L, D, D_FF), D ** -0.5),
        "mlp_w2": nrm((L, D_FF, D), D_FF ** -0.5),
        "ada_w": nrm((L, D, 6 * D), 0.5 * D ** -0.5),
        "ada_b": nrm((L, 6 * D), 0.02),
        "norm_mix_pre": 1.0 + nrm((L, D), 0.02),
        "norm_mix_post": 1.0 + nrm((L, D), 0.02),
        "norm_ffn_pre": 1.0 + nrm((L, D), 0.02),
        "norm_ffn_post": 1.0 + nrm((L, D), 0.02),
    }


def reference(x, c, ctx, c_ctx, w_in, rw_mu, rw_w0, rw_w_up, rw_a0, rw_a_up, rw_g_up,
              rw_k_k, rw_k_a, rw_r_k, rw_gn_w, rw_gn_b, rw_vres_down, rw_vres_up, rw_vres_bias,
              rw_out, gla_conv, gla_alpha_up, gla_alpha_bias, gla_norm_w, gla_out, merge_out,
              mlp_w1, mlp_w2, ada_w, ada_b, norm_mix_pre, norm_mix_post, norm_ffn_pre,
              norm_ffn_post):
    rows = x.shape[1] // GRID_W
    x_lat, x_ctx = x, ctx
    v_first = (None, None)
    for l in range(DEPTH):
        last = l == DEPTH - 1
        lp = {"w_in": w_in[l], "rw_mu": rw_mu[l], "rw_w0": rw_w0[l], "rw_w_up": rw_w_up[l],
              "rw_a0": rw_a0[l], "rw_a_up": rw_a_up[l], "rw_g_up": rw_g_up[l],
              "rw_k_k": rw_k_k[l], "rw_k_a": rw_k_a[l], "rw_r_k": rw_r_k[l],
              "rw_gn_w": rw_gn_w[l], "rw_gn_b": rw_gn_b[l], "rw_out": rw_out[l],
              "gla_conv": gla_conv[l], "gla_alpha_up": gla_alpha_up[l],
              "gla_alpha_bias": gla_alpha_bias[l], "gla_norm_w": gla_norm_w[l],
              "gla_out": gla_out[l], "merge_out": merge_out[l]}
        if l > 0:
            lp["rw_vres_down"] = rw_vres_down[l - 1]
            lp["rw_vres_up"] = rw_vres_up[l - 1]
            lp["rw_vres_bias"] = rw_vres_bias[l - 1]
        mod_lat = (jax.nn.silu(c) @ ada_w[l] + ada_b[l])[:, None, :]
        mod_ctx = jax.nn.silu(c_ctx) @ ada_w[l] + ada_b[l]
        sh_m, sc_m, g_m, sh_f, sc_f, g_f = jnp.split(mod_lat, 6, axis=-1)
        csh_m, csc_m, cg_m, csh_f, csc_f, cg_f = jnp.split(mod_ctx, 6, axis=-1)

        h_lat = modulate(x_lat, norm_mix_pre[l], sh_m, sc_m)
        h_ctx = modulate(x_ctx, norm_mix_pre[l], csh_m, csc_m)
        m_lat, m_ctx, v_new = token_mixer(h_lat, h_ctx, v_first, lp, l, rows, not last)
        if l == 0:
            v_first = v_new
        x_lat = x_lat + g_m * rms_norm(m_lat, norm_mix_post[l])
        f_lat = sq_relu_mlp(modulate(x_lat, norm_ffn_pre[l], sh_f, sc_f), mlp_w1[l], mlp_w2[l])
        x_lat = x_lat + g_f * rms_norm(f_lat, norm_ffn_post[l])
        if not last:
            x_ctx = x_ctx + cg_m * rms_norm(m_ctx, norm_mix_post[l])
            f_ctx = sq_relu_mlp(modulate(x_ctx, norm_ffn_pre[l], csh_f, csc_f), mlp_w1[l], mlp_w2[l])
            x_ctx = x_ctx + cg_f * rms_norm(f_ctx, norm_ffn_post[l])
    return x_lat
```

```cpp
#include <hip/hip_runtime.h>
#include <hip/hip_cooperative_groups.h>
#include <cstdio>
namespace cg = cooperative_groups;

#ifndef MEGA
#define MEGA 1
#endif
#ifndef DBG_REP
#define DBG_REP 0
#endif
#ifndef DBG_HI
#define DBG_HI 0
#define DBG_OFF (OFF_ARENA + A_KV)
#define DBG_N (NLAT * DM)
#endif

#define LAS __attribute__((address_space(3)))
typedef unsigned short bf16_t;
typedef short bf16x8 __attribute__((ext_vector_type(8)));
typedef float f32x4 __attribute__((ext_vector_type(4)));
typedef unsigned u32x4 __attribute__((ext_vector_type(4)));
typedef unsigned u32x2 __attribute__((ext_vector_type(2)));

constexpr int DM = 1024, NB = 4, SEQ = 4096, CTX = 256, NLAT = NB * SEQ, NCTX = NB * CTX, NTOK = NLAT + NCTX;
constexpr int INC = 5536, DFF = 4096;
constexpr int LDP = 3584;
constexpr int P_R = 0, P_K = 512, P_V = 1024, P_LRIN = 1536, P_GQ = 1920, P_GK = 2176, P_GV = 2432, P_ALF = 2944, P_ALB = 2960, P_GG = 2976;
constexpr int NTHREADS = 512;
constexpr int LDS_BYTES = 147456;

enum { I_X = 0, I_C, I_CTX, I_CCTX, I_WIN, I_MU, I_W0, I_WUP, I_A0, I_AUP, I_GUP, I_KK, I_KA, I_RK, I_GNW, I_GNB, I_VDN, I_VUP, I_VB, I_RWO, I_CONV, I_ALUP, I_ALB,
       I_GNORM, I_GLO, I_MRG, I_W1, I_W2, I_ADAW, I_ADAB, I_NMPRE, I_NMPOST, I_NFPRE, I_NFPOST, N_IN };

struct PR { const float* in[N_IN]; float* out; unsigned char* ws; };

constexpr size_t UU = (size_t)NTOK * 1024 * 2;
constexpr size_t OFF_XC = 0;
constexpr size_t OFF_VF = OFF_XC + (size_t)NCTX * DM * 4;
constexpr size_t OFF_MOD = OFF_VF + (size_t)NTOK * 512 * 2;
constexpr size_t OFF_MODP = OFF_MOD + 2 * 5 * 6144 * 4;
constexpr size_t OFF_KINV = OFF_MODP + 8 * 2 * 5 * 6144 * 4;
constexpr size_t OFF_BON = OFF_KINV + (size_t)NTOK * 8 * 4;
constexpr size_t OFF_GDEC = OFF_BON + 2 * (size_t)NTOK * 8 * 4;
constexpr size_t OFF_BAR = OFF_GDEC + 2176 * 64 * 4;
constexpr size_t OFF_WMIX = OFF_BAR + 16384;
constexpr size_t W_WIN = 0, W_GRW = W_WIN + (size_t)LDP * 1024 * 2, W_GGLA = W_GRW + 1024 * 1024 * 2, W_RWO = W_GGLA + 1024 * 1024 * 2, W_GLO = W_RWO + 1024 * 512 * 2,
                 W_MRG = W_GLO + 1024 * 512 * 2, W_BD = W_MRG + 1024 * 1024 * 2, W_VD = W_BD + 2560 * 384 * 2, W_VU = W_VD + 256 * 512 * 2, W_MIX_END = W_VU + 512 * 256 * 2;
constexpr size_t OFF_ARENA = OFF_WMIX + W_MIX_END;
constexpr size_t A_P = 0, A_H = UU * 7 / 2, A_YG = UU * 7 / 2, A_KV = UU * 4, A_RKVS = UU * 4, A_AS = UU * 11 / 2, A_VDB = UU * 47 / 8, A_LR = 0, A_G = UU * 2, A_YF = UU * 5 / 2,
                 A_YB = UU * 3, A_HR = 0, A_G1 = UU, A_G2 = UU * 4, A_M = UU * 5, A_H2 = 0, A_WMLP = UU, A_U = UU * 3 / 2, A_F = 0, A_PART12 = UU * 2, A_PART15 = UU * 11 / 2;
constexpr size_t WS_NEED = OFF_ARENA + UU * 49 / 8;

__device__ __forceinline__ int otid() { int t = threadIdx.x; asm volatile("" : "+v"(t)); return t; }
__device__ __forceinline__ float bf2f(bf16_t v) { return __uint_as_float(((unsigned)v) << 16); }
typedef __bf16 hbf2_t __attribute__((ext_vector_type(2)));
typedef float hf2_t __attribute__((ext_vector_type(2)));
__device__ __forceinline__ unsigned cvt_pk_bf16(float lo, float hi) { const hf2_t v = {lo, hi}; return __builtin_bit_cast(unsigned, __builtin_convertvector(v, hbf2_t)); }
__device__ __forceinline__ bf16_t f2bf(float f) { return (bf16_t)(cvt_pk_bf16(f, 0.f) & 0xffffu); }
__device__ __forceinline__ float lo_bf(unsigned u) { return __uint_as_float(u << 16); }
__device__ __forceinline__ float hi_bf(unsigned u) { return __uint_as_float(u & 0xffff0000u); }
__device__ __forceinline__ float sigm(float x) { return __builtin_amdgcn_rcpf(1.f + __expf(-x)); }
__device__ __forceinline__ float siluf(float x) { return x * sigm(x); }
__device__ __forceinline__ float wave_sum(float v) {
#pragma unroll
    for (int o = 32; o > 0; o >>= 1) v += __shfl_xor(v, o);
    return v;
}
template <int CTRL> __device__ __forceinline__ float dppf(float x) { return __int_as_float(__builtin_amdgcn_update_dpp(0, __float_as_int(x), CTRL, 0xf, 0xf, true)); }
__device__ __forceinline__ float row16_sum(float x) {
    x += dppf<0x128>(x); x += dppf<0x124>(x); x += dppf<0x122>(x); x += dppf<0x121>(x); return x;
}
__device__ __forceinline__ int tok_of(int s, int p, int colorder) {
    if (s >= 4) return NLAT + (s - 4) * CTX + p;
    const int t = colorder ? (((p & 63) << 6) | (p >> 6)) : p;
    return s * SEQ + t;
}

namespace pg8 {
constexpr int BM = 256, BK = 64, HALF = 128, HTB = HALF * BK * 2, NXCD = 8, WGM = 8;
__host__ __device__ __forceinline__ int lds_byte(int r, int c) { const int st = (r >> 4) * 2 + (c >> 5), rr = r & 15, cc = c & 31, ob = rr * 64 + cc * 2; return st * 1024 + (ob ^ (((ob >> 9) & 1) << 5)); }
__host__ __device__ __forceinline__ void stage_rc(int b, int& R, int& C) { const int st = b / 1024, sb = b % 1024, swz = sb ^ (((sb >> 9) & 1) << 5); R = (st >> 1) * 16 + swz / 64; C = (st & 1) * 32 + (swz % 64) / 2; }
__host__ __device__ __forceinline__ int perm32(int rho) { const int n = rho >> 4, i = rho & 15; return 8 * (i >> 2) + 4 * n + (i & 3); }
struct Unit { int pm, pn; };
struct Gemm { const bf16_t* A; const bf16_t* Bt; int M, N, K, lda, ldb; };
struct StaticOrder {
    int nM, nN, nwg, G, c;
    __device__ void init(int M, int N, int G_, int c_) { nM = M / BM; nN = N / BM; nwg = nM * nN; G = G_; c = c_; }
    __device__ bool next(int i, Unit& u) const {
        const long L = (long)i * G + c; if (L >= nwg) return false;
        int wgid = (int)L; { const int q = nwg / NXCD, r = nwg % NXCD, xcd = wgid % NXCD, off = wgid / NXCD; wgid = (xcd < r ? xcd * (q + 1) : r * (q + 1) + (xcd - r) * q) + off; }
        const int nig = WGM * nN, gid = wgid / nig, fm = gid * WGM, gsz = (nM - fm) < WGM ? (nM - fm) : WGM;
        u.pm = fm + ((wgid % nig) % gsz); u.pn = (wgid % nig) / gsz; return true;
    }
};

template <class Epi>
__device__ __forceinline__ void gemm_phase(LAS unsigned char* lds, const Gemm g, const StaticOrder& S, const Epi& E) {
    int tid = threadIdx.x; asm volatile("" : "+v"(tid));
    const int wid = __builtin_amdgcn_readfirstlane(tid >> 6), lane = tid & 63, wr = wid >> 2, wc = wid & 3, fr = lane & 15, fq = lane >> 4;
    int K = g.K; asm volatile("" : "+s"(K));
    const int nt = K / BK;
    unsigned voffA[2], voffB[2];
#pragma unroll
    for (int i = 0; i < 2; ++i) { int R, C; stage_rc(tid * 16 + i * 8192, R, C); const int Rb = (R & ~31) + perm32(R & 31);
        voffA[i] = (unsigned)(R * g.lda + C) * 2u; voffB[i] = (unsigned)(Rb * g.ldb + C) * 2u; }
    const size_t kstep = (size_t)(BK * 2);
    const size_t hstepA = (size_t)HALF * g.lda * 2, hstepB = (size_t)HALF * g.ldb * 2;
    const size_t tstepA = 2 * hstepA, tstepB = 2 * hstepB;
    const unsigned ldsw = (unsigned)wid * 1024u;
    const int aoff = lds_byte(wr * 64 + fr, fq * 8), boff = lds_byte(wc * 32 + fr, fq * 8);
#define PG8_SA(b, h) (((b) * 2 + (h)) * HTB)
#define PG8_SB(b, h) ((4 + (b) * 2 + (h)) * HTB)
#define PG8_STAGE(bufoff, gbase, voff) do { _Pragma("unroll") for (int _i = 0; _i < 2; ++_i) \
        __builtin_amdgcn_global_load_lds((const unsigned*)((const char*)(gbase) + (voff)[_i]), (LAS unsigned*)(lds + (bufoff) + ldsw + _i * 8192), 16, 0, 0); } while (0)
#define PG8_LDA(dst, b, h) do { _Pragma("unroll") for (int m = 0; m < 4; ++m) _Pragma("unroll") for (int k = 0; k < 2; ++k) dst[m][k] = *(const LAS bf16x8*)(lds + PG8_SA(b, h) + aoff + m * 2048 + k * 1024); } while (0)
#define PG8_LDB(dst, b, h) do { _Pragma("unroll") for (int n = 0; n < 2; ++n) _Pragma("unroll") for (int k = 0; k < 2; ++k) dst[n][k] = *(const LAS bf16x8*)(lds + PG8_SB(b, h) + boff + n * 2048 + k * 1024); } while (0)
#define PG8_MMA(ai, bj, At, Bt) do { __builtin_amdgcn_s_setprio(1); _Pragma("unroll") for (int m = 0; m < 4; ++m) _Pragma("unroll") for (int n = 0; n < 2; ++n) _Pragma("unroll") for (int k = 0; k < 2; ++k) \
        acc[ai][bj][m][n] = __builtin_amdgcn_mfma_f32_16x16x32_bf16(Bt[n][k], At[m][k], acc[ai][bj][m][n], 0, 0, 0); __builtin_amdgcn_s_setprio(0); } while (0)
#define PG8_WAIT_V(n) asm volatile("s_waitcnt vmcnt(" #n ")" ::: "memory")
#define PG8_WAIT_L(n) asm volatile("s_waitcnt lgkmcnt(" #n ")" ::: "memory")
#define PG8_BAR __builtin_amdgcn_s_barrier()
#define PG8_SCHED __builtin_amdgcn_sched_barrier(0)
    Unit cur, nxt; int ui = 0;
    if (!S.next(0, cur)) return;
    f32x4 acc[2][2][4][2];
#pragma unroll
    for (int a = 0; a < 2; ++a)
#pragma unroll
        for (int b = 0; b < 2; ++b)
#pragma unroll
            for (int m = 0; m < 4; ++m)
#pragma unroll
                for (int n = 0; n < 2; ++n) acc[a][b][m][n] = (f32x4){0.f, 0.f, 0.f, 0.f};
    bf16x8 At[4][2], B0[2][2], B1[2][2];
    const char* cA = (const char*)g.A + (size_t)cur.pm * tstepA; const char* cB = (const char*)g.Bt + (size_t)cur.pn * tstepB;
    PG8_STAGE(PG8_SB(0, 0), cB, voffB); PG8_STAGE(PG8_SA(0, 0), cA, voffA); PG8_STAGE(PG8_SB(0, 1), cB + hstepB, voffB); PG8_STAGE(PG8_SA(0, 1), cA + hstepA, voffA);
    if (wr == 1) PG8_BAR;
    PG8_WAIT_V(4); PG8_BAR;
    PG8_STAGE(PG8_SB(1, 0), cB + kstep, voffB); PG8_STAGE(PG8_SA(1, 0), cA + kstep, voffA); PG8_STAGE(PG8_SB(1, 1), cB + hstepB + kstep, voffB);
    PG8_WAIT_V(6); PG8_BAR;
    for (;;) {
        const bool has_next = S.next(ui + 1, nxt);
        const char* nA = has_next ? (const char*)g.A + (size_t)nxt.pm * tstepA : cA; const char* nB = has_next ? (const char*)g.Bt + (size_t)nxt.pn * tstepB : cB;
#pragma nounroll
        for (int t = 0; t < nt; t += 2) {
            const bool last = (t == nt - 2);
            const char* a1 = cA + (size_t)(t + 1) * kstep;
            const char* a2 = last ? nA : cA + (size_t)(t + 2) * kstep; const char* b2 = last ? nB : cB + (size_t)(t + 2) * kstep;
            const char* a3 = a2 + kstep; const char* b3 = b2 + kstep;
            PG8_LDB(B0, 0, 0); PG8_SCHED; PG8_LDA(At, 0, 0); PG8_STAGE(PG8_SA(1, 1), a1 + hstepA, voffA);
            PG8_WAIT_L(8); PG8_BAR; PG8_WAIT_L(0); PG8_MMA(0, 0, At, B0); PG8_BAR; PG8_SCHED;
            PG8_LDB(B1, 0, 1); PG8_STAGE(PG8_SB(0, 0), b2, voffB);
            PG8_BAR; PG8_WAIT_L(0); PG8_MMA(0, 1, At, B1); PG8_BAR;
            PG8_LDA(At, 0, 1); PG8_STAGE(PG8_SA(0, 0), a2, voffA);
            PG8_BAR; PG8_WAIT_L(0); PG8_MMA(1, 0, At, B0); PG8_BAR; PG8_SCHED;
            PG8_STAGE(PG8_SB(0, 1), b2 + hstepB, voffB);
            PG8_WAIT_V(6); PG8_BAR; PG8_MMA(1, 1, At, B1); PG8_BAR;
            PG8_LDB(B0, 1, 0); PG8_SCHED; PG8_LDA(At, 1, 0); PG8_STAGE(PG8_SA(0, 1), a2 + hstepA, voffA);
            PG8_WAIT_L(8); PG8_BAR; PG8_WAIT_L(0); PG8_MMA(0, 0, At, B0); PG8_BAR; PG8_SCHED;
            PG8_LDB(B1, 1, 1); PG8_STAGE(PG8_SB(1, 0), b3, voffB);
            PG8_BAR; PG8_WAIT_L(0); PG8_MMA(0, 1, At, B1); PG8_BAR;
            PG8_LDA(At, 1, 1); PG8_STAGE(PG8_SA(1, 0), a3, voffA);
            PG8_BAR; PG8_WAIT_L(0); PG8_MMA(1, 0, At, B0); PG8_BAR; PG8_SCHED;
            PG8_STAGE(PG8_SB(1, 1), b3 + hstepB, voffB);
            PG8_WAIT_V(6); PG8_BAR; PG8_MMA(1, 1, At, B1); PG8_BAR;
        }
        E(acc, cur, wr, wc, fr, fq);
        if (!has_next) break;
#pragma unroll
        for (int a = 0; a < 2; ++a)
#pragma unroll
            for (int b = 0; b < 2; ++b)
#pragma unroll
                for (int m = 0; m < 4; ++m)
#pragma unroll
                    for (int n = 0; n < 2; ++n) acc[a][b][m][n] = (f32x4){0.f, 0.f, 0.f, 0.f};
        cur = nxt; cA = nA; cB = nB; ++ui;
    }
    PG8_WAIT_V(0);
    if (wr == 0) PG8_BAR;
    PG8_BAR;
#undef PG8_SA
#undef PG8_SB
#undef PG8_STAGE
#undef PG8_LDA
#undef PG8_LDB
#undef PG8_MMA
#undef PG8_WAIT_V
#undef PG8_WAIT_L
#undef PG8_BAR
#undef PG8_SCHED
}
}

enum { E_STORE = 0, E_SIGMOID, E_MUL, E_FMA, E_RELU2, E_VRES, E_LR, E_F32 };
template <int MODE> struct Epi {
    bf16_t* d0; int ld0;
    const bf16_t* aux; int ldaux; const float* bias; const float* bias2;
    __device__ __forceinline__ void operator()(const f32x4 (&acc)[2][2][4][2], const pg8::Unit& u, int wr, int wc, int fr, int fq) const {
        const int row0 = u.pm * 256 + wr * 64 + fr; const int colt = u.pn * 256; bf16_t* base = d0; const int ld = ld0;
        const int col0 = colt + wc * 32 + 8 * fq;
#pragma unroll
        for (int ai = 0; ai < 2; ++ai)
#pragma unroll
            for (int m = 0; m < 4; ++m) {
                const int row = row0 + ai * 128 + m * 16;
#pragma unroll
                for (int bj = 0; bj < 2; ++bj) {
                    const int c = col0 + bj * 128;
                    if (MODE == E_F32) {
                        float* fp = (float*)d0 + (size_t)row * ld + c; *(f32x4*)fp = acc[ai][bj][m][0]; *(f32x4*)(fp + 4) = acc[ai][bj][m][1];
                        continue;
                    }
                    if (MODE == E_VRES) {
#pragma unroll
                        for (int hh = 0; hh < 2; ++hh) {
                            bf16_t* p4 = base + (size_t)row * ld + c + 4 * hh;
                            const u32x2 o = *(const u32x2*)p4; const u32x2 g = *(const u32x2*)(aux + (size_t)row * ldaux + c + 4 * hh); const f32x4 bb = *(const f32x4*)(bias + c + 4 * hh);
                            const f32x4 a4 = acc[ai][bj][m][hh];
                            float r4[4];
#pragma unroll
                            for (int j = 0; j < 2; ++j) {
                                const float v0 = __uint_as_float(o[j] << 16), v1 = __uint_as_float(o[j] & 0xffff0000u), f0 = __uint_as_float(g[j] << 16), f1 = __uint_as_float(g[j] & 0xffff0000u);
                                r4[2 * j] = v0 + (f0 - v0) * sigm(bb[2 * j] + a4[2 * j]); r4[2 * j + 1] = v1 + (f1 - v1) * sigm(bb[2 * j + 1] + a4[2 * j + 1]); }
                            u32x2 w2; w2[0] = cvt_pk_bf16(r4[0], r4[1]); w2[1] = cvt_pk_bf16(r4[2], r4[3]);
                            *(u32x2*)p4 = w2;
                            __builtin_amdgcn_sched_barrier(0);
                        }
                        continue;
                    }
                    float v[8];
#pragma unroll
                    for (int j = 0; j < 4; ++j) { v[j] = acc[ai][bj][m][0][j]; v[4 + j] = acc[ai][bj][m][1][j]; }
                    bf16_t* ptr = base + (size_t)row * ld + c;
                    if (MODE == E_LR && colt >= 2048) {
                        ptr = (bf16_t*)aux + (size_t)row * ldaux + (c - 2048);
                    } else if (MODE == E_LR) {
                        const float* bp = (colt < 1024) ? bias + c : bias2 + (c - 1024);
                        const f32x4 b0 = *(const f32x4*)bp, b1 = *(const f32x4*)(bp + 4);
#pragma unroll
                        for (int j = 0; j < 4; ++j) { v[j] += b0[j]; v[4 + j] += b1[j]; }
                        if (colt < 1024) {
#pragma unroll
                            for (int j = 0; j < 8; ++j) { const float sp = fmaxf(-v[j], 0.f) + __logf(1.f + __expf(-fabsf(v[j]))); v[j] = __expf(-sp - 0.5f); }
                        } else {
#pragma unroll
                            for (int j = 0; j < 8; ++j) v[j] = sigm(v[j]);
                        }
                    } else if (MODE == E_SIGMOID) {
#pragma unroll
                        for (int j = 0; j < 8; ++j) v[j] = sigm(v[j]);
                    } else if (MODE == E_RELU2) {
#pragma unroll
                        for (int j = 0; j < 8; ++j) { const float t = fmaxf(v[j], 0.f); v[j] = t * t; }
                    } else if (MODE == E_MUL) {
                        const u32x4 o = *(const u32x4*)ptr;
#pragma unroll
                        for (int j = 0; j < 4; ++j) { v[2 * j] *= __uint_as_float(o[j] << 16); v[2 * j + 1] *= __uint_as_float(o[j] & 0xffff0000u); }
                    } else if (MODE == E_FMA) {
                        const u32x4 o = *(const u32x4*)ptr; const u32x4 g = *(const u32x4*)(aux + (size_t)row * ldaux + c);
#pragma unroll
                        for (int j = 0; j < 4; ++j) { v[2 * j] = __uint_as_float(o[j] << 16) + __uint_as_float(g[j] << 16) * v[2 * j];
                            v[2 * j + 1] = __uint_as_float(o[j] & 0xffff0000u) + __uint_as_float(g[j] & 0xffff0000u) * v[2 * j + 1]; }
                    }
                    u32x4 w; w.x = cvt_pk_bf16(v[0], v[1]); w.y = cvt_pk_bf16(v[2], v[3]); w.z = cvt_pk_bf16(v[4], v[5]); w.w = cvt_pk_bf16(v[6], v[7]);
                    *(u32x4*)ptr = w;
                    if (MODE >= E_MUL) __builtin_amdgcn_sched_barrier(0);
                }
            }
    }
};
template <int MODE>
__device__ __forceinline__ void run_gemm(unsigned char* shm, const bf16_t* A, int lda, const bf16_t* Bt, int ldb, int M, int N, int K, const Epi<MODE>& E, int coff = 0) {
    pg8::Gemm g; g.A = A; g.Bt = Bt; g.M = M; g.N = N; g.K = K; g.lda = lda; g.ldb = ldb;
    pg8::StaticOrder S; S.init(M, N, (int)gridDim.x, (int)((blockIdx.x + gridDim.x - coff) % gridDim.x));
    pg8::gemm_phase<Epi<MODE>>((LAS unsigned char*)shm, g, S, E);
}
template <int MODE> __device__ __forceinline__ Epi<MODE> mk_epi(bf16_t* d0, int ld0, const bf16_t* aux = nullptr, int ldaux = 0, const float* bias = nullptr, const float* bias2 = nullptr) {
    Epi<MODE> e; e.bias2 = bias2; e.d0 = d0; e.ld0 = ld0; e.aux = aux; e.ldaux = ldaux; e.bias = bias; return e;
}

__device__ __forceinline__ int tconv_tiles(int K, int nrows) { return (K / 64) * (nrows / 64); }
__device__ __forceinline__ void tconv_tile(unsigned char* shm, const float* src, int sld, int c0, int K, int ncols, int nrows, bf16_t* dst, int ldd, int tile) {
    float* t = (float*)shm;
    const int nkt = K / 64, ti = tile % nkt, tj = tile / nkt;
    const int tid = otid();
    __syncthreads();
#pragma unroll
    for (int r = 0; r < 2; ++r) { const int e = tid + r * NTHREADS, i = e >> 4, c4 = e & 15, j = tj * 64 + c4 * 4;
        f32x4 v = {0.f, 0.f, 0.f, 0.f};
        if (j < ncols) v = *(const f32x4*)(src + (size_t)(ti * 64 + i) * sld + c0 + j);
        t[i * 65 + c4 * 4] = v[0]; t[i * 65 + c4 * 4 + 1] = v[1]; t[i * 65 + c4 * 4 + 2] = v[2]; t[i * 65 + c4 * 4 + 3] = v[3]; }
    __syncthreads();
    { const int jl = tid >> 3, ko = tid & 7;
        float f[8];
#pragma unroll
        for (int m = 0; m < 8; ++m) f[m] = t[(ko * 8 + m) * 65 + jl];
        u32x4 w; w.x = cvt_pk_bf16(f[0], f[1]); w.y = cvt_pk_bf16(f[2], f[3]); w.z = cvt_pk_bf16(f[4], f[5]); w.w = cvt_pk_bf16(f[6], f[7]);
        *(u32x4*)(dst + (size_t)(tj * 64 + jl) * ldd + ti * 64 + ko * 8) = w; }
}
__device__ __forceinline__ void ph_wconv_mix(const PR& p, unsigned char* shm, int l) {
    unsigned char* W = p.ws + OFF_WMIX;
    const float* win = p.in[I_WIN] + (size_t)l * DM * INC;
    const int n0 = tconv_tiles(1024, LDP), n1 = n0 + tconv_tiles(1024, 1024), n2 = n1 + tconv_tiles(1024, 1024), n3 = n2 + tconv_tiles(512, 1024), n4 = n3 + tconv_tiles(512, 1024), n5 = n4 + tconv_tiles(1024, 1024);
    for (int it = blockIdx.x; it < n5; it += gridDim.x) {
        if (it < n0) tconv_tile(shm, win, INC, 0, 1024, 3488, LDP, (bf16_t*)(W + W_WIN), 1024, it);
        else if (it < n1) tconv_tile(shm, win, INC, 3488, 1024, 1024, 1024, (bf16_t*)(W + W_GRW), 1024, it - n0);
        else if (it < n2) tconv_tile(shm, win, INC, 4512, 1024, 1024, 1024, (bf16_t*)(W + W_GGLA), 1024, it - n1);
        else if (it < n3) tconv_tile(shm, p.in[I_RWO] + (size_t)l * 512 * 1024, 1024, 0, 512, 1024, 1024, (bf16_t*)(W + W_RWO), 512, it - n2);
        else if (it < n4) tconv_tile(shm, p.in[I_GLO] + (size_t)l * 512 * 1024, 1024, 0, 512, 1024, 1024, (bf16_t*)(W + W_GLO), 512, it - n3);
        else tconv_tile(shm, p.in[I_MRG] + (size_t)l * 1024 * 1024, 1024, 0, 1024, 1024, 1024, (bf16_t*)(W + W_MRG), 1024, it - n4);
    }
    const size_t gt = (size_t)blockIdx.x * NTHREADS + otid(), gs = (size_t)gridDim.x * NTHREADS;
    bf16_t* bd = (bf16_t*)(W + W_BD);
    for (size_t e = gt; e < (size_t)2560 * 384; e += gs) {
        const int row = (int)(e / 384), k = (int)(e % 384); float v = 0.f;
        if (row < 2048) { const int blk = row >> 9, j = row & 511; if ((k >> 6) == blk) { const int kk = k & 63;
                const float* src = (blk < 2) ? p.in[I_WUP] + ((size_t)(l * 2 + blk) * 64) * 512 : p.in[I_AUP] + ((size_t)(l * 2 + (blk - 2)) * 64) * 512; v = src[(size_t)kk * 512 + j]; } }
        else { const int j = row - 2048; if (k >= 256) v = p.in[I_GUP][((size_t)l * 128 + (k - 256)) * 512 + j]; }
        bd[e] = f2bf(v);
    }
    if (l >= 1) {
        bf16_t* vd = (bf16_t*)(W + W_VD); bf16_t* vu = (bf16_t*)(W + W_VU);
        const float* dn = p.in[I_VDN] + (size_t)(l - 1) * 512 * 32; const float* up = p.in[I_VUP] + (size_t)(l - 1) * 32 * 512;
        for (size_t e = gt; e < (size_t)256 * 512; e += gs) { const int row = (int)(e / 512), k = (int)(e % 512); vd[e] = f2bf(row < 32 ? dn[(size_t)k * 32 + row] : 0.f); }
        for (size_t e = gt; e < (size_t)512 * 256; e += gs) { const int row = (int)(e / 256), k = (int)(e % 256); vu[e] = f2bf(k < 32 ? up[(size_t)k * 512 + row] : 0.f); }
    }
}
__device__ __forceinline__ void ph_wconv_mlp(const PR& p, unsigned char* shm, int l) {
    bf16_t* w1 = (bf16_t*)(p.ws + OFF_ARENA + A_WMLP); bf16_t* w2 = w1 + (size_t)DFF * DM;
    const int n0 = tconv_tiles(1024, 4096), n1 = n0 + tconv_tiles(4096, 1024);
    for (int it = blockIdx.x; it < n1; it += gridDim.x) {
        if (it < n0) tconv_tile(shm, p.in[I_W1] + (size_t)l * DM * DFF, DFF, 0, 1024, 4096, 4096, w1, 1024, it);
        else tconv_tile(shm, p.in[I_W2] + (size_t)l * DFF * DM, DM, 0, 4096, 1024, 1024, w2, 4096, it - n0);
    }
}

__device__ __forceinline__ void ph_mod_partial(const PR& p, unsigned char* shm) {
    float* sc = (float*)shm;
    float* modp = (float*)(p.ws + OFF_MODP);
    for (int it = blockIdx.x; it < 2 * 12 * 8; it += gridDim.x) {
        const int ks = it & 7, cb = (it >> 3) % 12, l = it / 96;
        __syncthreads();
        for (int e = otid(); e < 5 * 128; e += NTHREADS) { const int j = e >> 7, k = ks * 128 + (e & 127); const float cv = (j < 4) ? p.in[I_C][j * 1024 + k] : p.in[I_CCTX][k]; sc[e] = siluf(cv); }
        __syncthreads();
        const int col = cb * 512 + otid();
        const float* w = p.in[I_ADAW] + ((size_t)l * 1024 + ks * 128) * 6144 + col;
        float a0 = 0, a1 = 0, a2 = 0, a3 = 0, a4 = 0;
#pragma unroll 8
        for (int k = 0; k < 128; ++k) { const float wv = w[(size_t)k * 6144]; a0 += sc[k] * wv; a1 += sc[128 + k] * wv; a2 += sc[256 + k] * wv; a3 += sc[384 + k] * wv; a4 += sc[512 + k] * wv; }
        float* o = modp + ((size_t)(ks * 2 + l) * 5) * 6144 + col;
        o[0] = a0; o[6144] = a1; o[2 * 6144] = a2; o[3 * 6144] = a3; o[4 * 6144] = a4;
    }
}
__device__ __forceinline__ void ph_mod_reduce(const PR& p) {
    const float* modp = (const float*)(p.ws + OFF_MODP); float* mod = (float*)(p.ws + OFF_MOD);
    for (int e = blockIdx.x * NTHREADS + otid(); e < 2 * 5 * 6144; e += gridDim.x * NTHREADS) {
        const int l = e / (5 * 6144), col = e % 6144; float a = p.in[I_ADAB][l * 6144 + col];
#pragma unroll
        for (int ks = 0; ks < 8; ++ks) a += modp[(size_t)ks * 2 * 5 * 6144 + e];
        mod[e] = a;
    }
}

__device__ __forceinline__ void ph_rowwise(const float* xs_lat, const float* xs_ctx, float* xd_lat, float* xd_ctx, const bf16_t* Y, const float* norm_post, int gate_idx,
                           const float* norm_pre, int shift_idx, int scale_idx, bf16_t* Hout, const float* mod, const float* mod_pre, int nrows, const float* Ypart = nullptr, bf16_t* Hctx = nullptr) {
    const int wave = otid() >> 6, lane = otid() & 63;
    auto load_row = [&](int n, float (&x)[16], float (&y)[16]) {
        const float* xs = (n < NLAT) ? xs_lat + (size_t)n * DM : xs_ctx + (size_t)(n - NLAT) * DM;
#pragma unroll
        for (int i = 0; i < 4; ++i) { const f32x4 t = *(const f32x4*)(xs + i * 256 + lane * 4); x[4 * i] = t[0]; x[4 * i + 1] = t[1]; x[4 * i + 2] = t[2]; x[4 * i + 3] = t[3]; }
        if (Y) {
            if (Ypart && n >= NLAT) {
#pragma unroll
                for (int i = 0; i < 4; ++i) { f32x4 a = {0.f, 0.f, 0.f, 0.f};
#pragma unroll
                    for (int sl = 0; sl < 4; ++sl) a += *(const f32x4*)(Ypart + ((size_t)sl * NCTX + (n - NLAT)) * DM + i * 256 + lane * 4);
                    y[4 * i] = a[0]; y[4 * i + 1] = a[1]; y[4 * i + 2] = a[2]; y[4 * i + 3] = a[3]; }
            } else {
#pragma unroll
                for (int i = 0; i < 4; ++i) { const u32x2 t = *(const u32x2*)(Y + (size_t)n * DM + i * 256 + lane * 4);
                    y[4 * i] = lo_bf(t[0]); y[4 * i + 1] = hi_bf(t[0]); y[4 * i + 2] = lo_bf(t[1]); y[4 * i + 3] = hi_bf(t[1]); }
            }
        }
    };
    auto finish_row = [&](int n, float (&x)[16], float (&y)[16]) {
        const float* md = mod + (size_t)((n < NLAT) ? (n >> 12) : 4) * 6144;
        const float* mdp = mod_pre + (size_t)((n < NLAT) ? (n >> 12) : 4) * 6144;
        if (Y) {
            float ss = 0.f;
#pragma unroll
            for (int i = 0; i < 16; ++i) ss += y[i] * y[i];
            ss = wave_sum(ss);
            const float rstd = rsqrtf(ss * (1.f / 1024.f) + 1e-6f);
            float* xd = (n < NLAT) ? xd_lat + (size_t)n * DM : xd_ctx + (size_t)(n - NLAT) * DM;
#pragma unroll
            for (int i = 0; i < 4; ++i) { const int c = i * 256 + lane * 4; const f32x4 np = *(const f32x4*)(norm_post + c); const f32x4 gt = *(const f32x4*)(md + gate_idx * 1024 + c);
                f32x4 o;
#pragma unroll
                for (int j = 0; j < 4; ++j) { x[4 * i + j] += gt[j] * (y[4 * i + j] * rstd * np[j]); o[j] = x[4 * i + j]; }
                *(f32x4*)(xd + c) = o; }
        }
        if (Hout) {
            float ss = 0.f;
#pragma unroll
            for (int i = 0; i < 16; ++i) ss += x[i] * x[i];
            ss = wave_sum(ss);
            const float rstd = rsqrtf(ss * (1.f / 1024.f) + 1e-6f);
#pragma unroll
            for (int i = 0; i < 4; ++i) { const int c = i * 256 + lane * 4; const f32x4 np = *(const f32x4*)(norm_pre + c); const f32x4 sh = *(const f32x4*)(mdp + shift_idx * 1024 + c); const f32x4 sc = *(const f32x4*)(mdp + scale_idx * 1024 + c);
                float h[4];
#pragma unroll
                for (int j = 0; j < 4; ++j) h[j] = x[4 * i + j] * rstd * np[j] * (1.f + sc[j]) + sh[j];
                u32x2 o; o[0] = cvt_pk_bf16(h[0], h[1]); o[1] = cvt_pk_bf16(h[2], h[3]);
                bf16_t* hp = (Hctx && n >= NLAT) ? Hctx + (size_t)(n - NLAT) * DM : Hout + (size_t)n * DM;
                *(u32x2*)(hp + c) = o; }
        }
    };
    const int stride = gridDim.x * 8;
    for (int n = blockIdx.x * 8 + wave; n < nrows; n += 2 * stride) {
        const int n1 = n + stride; const bool has1 = n1 < nrows;
        float xa[16], ya[16], xb[16], yb[16];
        load_row(n, xa, ya); if (has1) load_row(n1, xb, yb);
        finish_row(n, xa, ya); if (has1) finish_row(n1, xb, yb);
    }
}

constexpr int GS = 72;
constexpr int L_QDF = 0, L_QDB = 9216, L_KIF = 18432, L_KIB = 27648, L_VT = 36864, L_KEF = 55296, L_KEB = 64512, L_STF = 73728, L_STB = 92160, L_CUMF = 73728, L_CUMB = 90112, L_ALD = 106496, L_OX = 0;
constexpr int L_RAW = 110592, L_TOT = 144384;
struct GlaRaw { u32x4 v[5]; u32x4 a; };
__device__ __forceinline__ void gla_issue(const PR& p, int l, int cid, int h, GlaRaw& g) {
    const bf16_t* P = (const bf16_t*)(p.ws + OFF_ARENA + A_P);
    const int colorder = !(l & 1);
    const int s = (cid < 256) ? (cid >> 6) : 4 + ((cid - 256) >> 2), nch = (cid < 256) ? (cid & 63) : ((cid - 256) & 3), T = (s < 4) ? SEQ : CTX, p0 = nch * 64;
    const int tid = otid();
#pragma unroll
    for (int k = 0; k < 5; ++k) {
        const int e = tid + k * NTHREADS;
        const int r = e >> 5, c16 = e & 31, pp = p0 - 1 + r, ch0 = c16 * 8;
        const int col = (ch0 < 64) ? (P_GQ + h * 64 + ch0) : (ch0 < 128) ? (P_GK + h * 64 + (ch0 - 64)) : (P_GV + h * 128 + (ch0 - 128));
        u32x4 v = {0u, 0u, 0u, 0u};
        if (e < 66 * 32 && pp >= 0 && pp < T) v = *(const u32x4*)(P + (size_t)tok_of(s, pp, colorder) * LDP + col);
        g.v[k] = v;
    }
    g.a = (u32x4){0u, 0u, 0u, 0u};
    if (tid < 256) { const int r = tid >> 2, c = tid & 3; g.a = *(const u32x4*)(P + (size_t)tok_of(s, p0 + r, colorder) * LDP + P_ALF + c * 8); }
}
__device__ __forceinline__ void gla_stage(const PR& p, unsigned char* shm, int l, int cid, int h, bool need_qd, const GlaRaw& g) {
    const bf16_t* P = (const bf16_t*)(p.ws + OFF_ARENA + A_P);
    const int colorder = !(l & 1);
    const int s = (cid < 256) ? (cid >> 6) : 4 + ((cid - 256) >> 2), nch = (cid < 256) ? (cid & 63) : ((cid - 256) & 3), T = (s < 4) ? SEQ : CTX, p0 = nch * 64;
    const int tid = otid();
    float* cumF = (float*)(shm + L_CUMF); float* cumB = (float*)(shm + L_CUMB); const bf16_t* ald = (const bf16_t*)(shm + L_ALD); float* tot = (float*)(shm + L_TOT);
    const bf16_t* raw = (const bf16_t*)(shm + L_RAW);
    __syncthreads();
#pragma unroll
    for (int k = 0; k < 5; ++k) { const int e = tid + k * NTHREADS; if (e < 66 * 32) *(u32x4*)(shm + L_RAW + ((e >> 5) * 256 + (e & 31) * 8) * 2) = g.v[k]; }
    if (tid < 256) *(u32x4*)(shm + L_ALD + ((tid >> 2) * 32 + (tid & 3) * 8) * 2) = g.a;
    __syncthreads();
    const int key = tid & 63, d = (tid >> 6) & 1, tg = tid >> 7;
    float la[16];
    {
        const float* up = p.in[I_ALUP] + ((size_t)(l * 2 + d) * 16) * 256 + h * 64 + key; const float bias = p.in[I_ALB][(l * 2 + d) * 256 + h * 64 + key];
        typedef __bf16 hbf8_t __attribute__((ext_vector_type(8)));
        hbf2_t wp[8];
#pragma unroll
        for (int k = 0; k < 8; ++k) { const hf2_t w2 = {up[(size_t)(2 * k) * 256], up[(size_t)(2 * k + 1) * 256]}; wp[k] = __builtin_convertvector(w2, hbf2_t); }
#pragma unroll
        for (int i = 0; i < 16; ++i) {
            const hbf8_t x0 = *(const hbf8_t*)(ald + (tg * 16 + i) * 32 + d * 16), x1 = *(const hbf8_t*)(ald + (tg * 16 + i) * 32 + d * 16 + 8);
            float a = bias;
            a = __builtin_amdgcn_fdot2_f32_bf16(__builtin_shufflevector(x0, x0, 0, 1), wp[0], a, false);
            a = __builtin_amdgcn_fdot2_f32_bf16(__builtin_shufflevector(x0, x0, 2, 3), wp[1], a, false);
            a = __builtin_amdgcn_fdot2_f32_bf16(__builtin_shufflevector(x0, x0, 4, 5), wp[2], a, false);
            a = __builtin_amdgcn_fdot2_f32_bf16(__builtin_shufflevector(x0, x0, 6, 7), wp[3], a, false);
            a = __builtin_amdgcn_fdot2_f32_bf16(__builtin_shufflevector(x1, x1, 0, 1), wp[4], a, false);
            a = __builtin_amdgcn_fdot2_f32_bf16(__builtin_shufflevector(x1, x1, 2, 3), wp[5], a, false);
            a = __builtin_amdgcn_fdot2_f32_bf16(__builtin_shufflevector(x1, x1, 4, 5), wp[6], a, false);
            a = __builtin_amdgcn_fdot2_f32_bf16(__builtin_shufflevector(x1, x1, 6, 7), wp[7], a, false);
            la[i] = -(fmaxf(-a, 0.f) + __logf(1.f + __expf(-fabsf(a)))) * (1.f / 16.f);
        }
        if (d == 0) {
#pragma unroll
            for (int i = 1; i < 16; ++i) la[i] += la[i - 1];
            tot[(0 * 4 + tg) * 64 + key] = la[15];
        } else {
#pragma unroll
            for (int i = 14; i >= 0; --i) la[i] += la[i + 1];
            tot[(1 * 4 + tg) * 64 + key] = la[0];
        }
    }
    __syncthreads();
    {
        float off = 0.f;
#pragma unroll
        for (int g = 0; g < 4; ++g) { const float t = tot[(d * 4 + g) * 64 + key]; off += (d == 0 ? (g < tg) : (g > tg)) ? t : 0.f; }
        float* dst = d ? cumB : cumF;
#pragma unroll
        for (int i = 0; i < 16; ++i) dst[(tg * 16 + i) * 64 + key] = la[i] + off;
    }
    __syncthreads();
    {
        const int ch = tid & 255, th = tid >> 8;
        const int cc = (ch < 64) ? (h * 64 + ch) : (ch < 128) ? (256 + h * 64 + (ch - 64)) : (512 + h * 128 + (ch - 128));
        const float* cw = p.in[I_CONV] + (size_t)l * 3 * 1024; const float w0 = cw[cc], w1 = cw[1024 + cc], w2 = cw[2048 + cc];
        const int i0 = th * 32;
        float fm = bf2f(raw[(i0) * 256 + ch]), f0 = bf2f(raw[(i0 + 1) * 256 + ch]);
        bf16_t* qdF = (bf16_t*)(shm + L_QDF); bf16_t* qdB = (bf16_t*)(shm + L_QDB); bf16_t* kiF = (bf16_t*)(shm + L_KIF); bf16_t* kiB = (bf16_t*)(shm + L_KIB);
        bf16_t* vT = (bf16_t*)(shm + L_VT); bf16_t* keF = (bf16_t*)(shm + L_KEF); bf16_t* keB = (bf16_t*)(shm + L_KEB);
        const float totF = (ch >= 64 && ch < 128) ? cumF[63 * 64 + (ch - 64)] : 0.f, totB = (ch >= 64 && ch < 128) ? cumB[ch - 64] : 0.f;
#pragma unroll 4
        for (int i = i0; i < i0 + 32; ++i) {
            const float fp = bf2f(raw[(i + 2) * 256 + ch]);
            const float y = siluf(w0 * fm + w1 * f0 + w2 * fp);
            fm = f0; f0 = fp;
            if (ch < 64) { if (need_qd) { const float q = y * 0.125f; qdF[i * GS + ch] = f2bf(q * __expf(cumF[i * 64 + ch])); qdB[i * GS + ch] = f2bf(q * __expf(cumB[i * 64 + ch])); } }
            else if (ch < 128) { const int kx = ch - 64; const float cf = cumF[i * 64 + kx], cb = cumB[i * 64 + kx];
                if (need_qd) { kiF[i * GS + kx] = f2bf(y * __expf(-cf)); kiB[i * GS + kx] = f2bf(y * __expf(-cb)); }
                else { keF[kx * GS + i] = f2bf(y * __expf(totF - cf)); keB[kx * GS + i] = f2bf(y * __expf(totB - cb)); } }
            else vT[(ch - 128) * GS + i] = f2bf(y);
        }
    }
    __syncthreads();
}
__device__ __forceinline__ bf16x8 lds_frag(const unsigned char* shm, int off, int row, int col) { return *(const bf16x8*)(shm + off + (row * GS + col) * 2); }

__device__ __forceinline__ void ph_gla_a(const PR& p, unsigned char* shm, int l) {
    bf16_t* KV = (bf16_t*)(p.ws + OFF_ARENA + A_KV); float* gdec = (float*)(p.ws + OFF_GDEC);
    const int wave = otid() >> 6, lane = otid() & 63, fr = lane & 15, fq = lane >> 4;
    GlaRaw graw; if (blockIdx.x < 272 * 4) gla_issue(p, l, blockIdx.x >> 2, blockIdx.x & 3, graw);
    for (int it = blockIdx.x; it < 272 * 4; it += gridDim.x) {
        const int cid = it >> 2, h = it & 3;
        gla_stage(p, shm, l, cid, h, false, graw);
        { const int itn = it + gridDim.x; if (itn < 272 * 4) gla_issue(p, l, itn >> 2, itn & 3, graw); }
        const bf16x8 a0 = lds_frag(shm, L_VT, wave * 16 + fr, fq * 8), a1 = lds_frag(shm, L_VT, wave * 16 + fr, 32 + fq * 8);
#pragma unroll
        for (int d = 0; d < 2; ++d)
#pragma unroll
            for (int nt = 0; nt < 4; ++nt) {
                const int off = d ? L_KEB : L_KEF;
                const bf16x8 b0 = lds_frag(shm, off, nt * 16 + fr, fq * 8), b1 = lds_frag(shm, off, nt * 16 + fr, 32 + fq * 8);
                f32x4 c = {0.f, 0.f, 0.f, 0.f};
                c = __builtin_amdgcn_mfma_f32_16x16x32_bf16(a0, b0, c, 0, 0, 0);
                c = __builtin_amdgcn_mfma_f32_16x16x32_bf16(a1, b1, c, 0, 0, 0);
                bf16_t* o = KV + ((size_t)(it * 2 + d) * 128) * 64;
#pragma unroll
                for (int j = 0; j < 4; ++j) o[(wave * 16 + fq * 4 + j) * 64 + nt * 16 + fr] = f2bf(c[j]);
            }
        if (otid() < 128) { const int d = otid() >> 6, key = otid() & 63; const float* cum = (const float*)(shm + (d ? L_CUMB : L_CUMF));
            gdec[(size_t)(it * 2 + d) * 64 + key] = __expf(d ? cum[key] : cum[63 * 64 + key]); }
    }
}
__device__ __forceinline__ void ph_gla_b(const PR& p) {
    unsigned* KV = (unsigned*)(p.ws + OFF_ARENA + A_KV); const float* gdec = (const float*)(p.ws + OFF_GDEC);
    for (int e = blockIdx.x * NTHREADS + otid(); e < 32 * 4096; e += gridDim.x * NTHREADS) {
        const int combo = e >> 12, pe = e & 4095;
        const int b = combo >> 3, h = (combo >> 1) & 3, d = combo & 1, key = (pe & 31) * 2;
        float s0 = 0.f, s1 = 0.f;
#pragma unroll
        for (int hb = 0; hb < 2; ++hb) {
            unsigned kv[34]; float d0[34], d1[34]; unsigned* ptr[34];
#pragma unroll
            for (int j = 0; j < 34; ++j) {
                const int i = hb * 34 + j;
                int cid; if (i < 4) cid = 256 + b * 4 + (d ? 3 - i : i); else cid = b * 64 + (d ? 63 - (i - 4) : (i - 4));
                const size_t ent = (size_t)((cid * 4 + h) * 2 + d);
                ptr[j] = KV + ent * 4096 + pe; kv[j] = *ptr[j]; d0[j] = gdec[ent * 64 + key]; d1[j] = gdec[ent * 64 + key + 1];
            }
#pragma unroll
            for (int j = 0; j < 34; ++j) {
                *ptr[j] = cvt_pk_bf16(s0, s1);
                s0 = s0 * d0[j] + lo_bf(kv[j]); s1 = s1 * d1[j] + hi_bf(kv[j]);
            }
        }
    }
}
__device__ __forceinline__ void ph_gla_c(const PR& p, unsigned char* shm, int l) {
    const bf16_t* P = (const bf16_t*)(p.ws + OFF_ARENA + A_P); const bf16_t* KV = (const bf16_t*)(p.ws + OFF_ARENA + A_KV); bf16_t* YG = (bf16_t*)(p.ws + OFF_ARENA + A_YG);
    const int colorder = !(l & 1);
    const int wave = otid() >> 6, lane = otid() & 63, fr = lane & 15, fq = lane >> 4;
    GlaRaw graw; if (blockIdx.x < 272 * 4) gla_issue(p, l, blockIdx.x >> 2, blockIdx.x & 3, graw);
    for (int it = blockIdx.x; it < 272 * 4; it += gridDim.x) {
        const int cid = it >> 2, h = it & 3;
        const int s = (cid < 256) ? (cid >> 6) : 4 + ((cid - 256) >> 2), nch = (cid < 256) ? (cid & 63) : ((cid - 256) & 3), p0 = nch * 64;
        gla_stage(p, shm, l, cid, h, true, graw);
        { const int itn = it + gridDim.x; if (itn < 272 * 4) gla_issue(p, l, itn >> 2, itn & 3, graw); }
        for (int e = otid(); e < 2 * 128 * 8; e += NTHREADS) { const int d = e >> 10, r = (e >> 3) & 127, c8 = e & 7;
            const u32x4 v = *(const u32x4*)(KV + ((size_t)(it * 2 + d) * 128 + r) * 64 + c8 * 8);
            *(u32x4*)(shm + (d ? L_STB : L_STF) + (r * GS + c8 * 8) * 2) = v; }
        {
            const int d = wave >> 2, mt = wave & 3; const int qoff = d ? L_QDB : L_QDF, koff = d ? L_KIB : L_KIF, poff = d ? L_KEB : L_KEF;
            const bf16x8 a0 = lds_frag(shm, qoff, mt * 16 + fr, fq * 8), a1 = lds_frag(shm, qoff, mt * 16 + fr, 32 + fq * 8);
            bf16_t* Pm = (bf16_t*)(shm + poff);
#pragma unroll
            for (int nt = 0; nt < 4; ++nt) {
                const bf16x8 b0 = lds_frag(shm, koff, nt * 16 + fr, fq * 8), b1 = lds_frag(shm, koff, nt * 16 + fr, 32 + fq * 8);
                f32x4 c = {0.f, 0.f, 0.f, 0.f};
                c = __builtin_amdgcn_mfma_f32_16x16x32_bf16(a0, b0, c, 0, 0, 0);
                c = __builtin_amdgcn_mfma_f32_16x16x32_bf16(a1, b1, c, 0, 0, 0);
#pragma unroll
                for (int j = 0; j < 4; ++j) { const int i = mt * 16 + fq * 4 + j, jj = nt * 16 + fr; const bool keep = d ? (jj >= i) : (jj <= i); Pm[i * GS + jj] = f2bf(keep ? c[j] : 0.f); }
            }
        }
        __syncthreads();
        f32x4 acc[8];
        {
            const int d = wave >> 2, mt = wave & 3; const int qoff = d ? L_QDB : L_QDF, poff = d ? L_KEB : L_KEF, soff = d ? L_STB : L_STF;
            const bf16x8 pa0 = lds_frag(shm, poff, mt * 16 + fr, fq * 8), pa1 = lds_frag(shm, poff, mt * 16 + fr, 32 + fq * 8);
            const bf16x8 qa0 = lds_frag(shm, qoff, mt * 16 + fr, fq * 8), qa1 = lds_frag(shm, qoff, mt * 16 + fr, 32 + fq * 8);
#pragma unroll
            for (int nt = 0; nt < 8; ++nt) {
                f32x4 c = {0.f, 0.f, 0.f, 0.f};
                c = __builtin_amdgcn_mfma_f32_16x16x32_bf16(pa0, lds_frag(shm, L_VT, nt * 16 + fr, fq * 8), c, 0, 0, 0);
                c = __builtin_amdgcn_mfma_f32_16x16x32_bf16(pa1, lds_frag(shm, L_VT, nt * 16 + fr, 32 + fq * 8), c, 0, 0, 0);
                c = __builtin_amdgcn_mfma_f32_16x16x32_bf16(qa0, lds_frag(shm, soff, nt * 16 + fr, fq * 8), c, 0, 0, 0);
                c = __builtin_amdgcn_mfma_f32_16x16x32_bf16(qa1, lds_frag(shm, soff, nt * 16 + fr, 32 + fq * 8), c, 0, 0, 0);
                acc[nt] = c;
            }
        }
        __syncthreads();
        float* ox = (float*)(shm + L_OX);
        if (wave >= 4) { const int mt = wave & 3;
#pragma unroll
            for (int nt = 0; nt < 8; ++nt)
#pragma unroll
                for (int j = 0; j < 4; ++j) ox[(mt * 16 + fq * 4 + j) * 128 + nt * 16 + fr] = acc[nt][j]; }
        __syncthreads();
        if (wave < 4) { const int mt = wave;
            float ss[4] = {0.f, 0.f, 0.f, 0.f};
#pragma unroll
            for (int nt = 0; nt < 8; ++nt)
#pragma unroll
                for (int j = 0; j < 4; ++j) { acc[nt][j] += ox[(mt * 16 + fq * 4 + j) * 128 + nt * 16 + fr]; ss[j] += acc[nt][j] * acc[nt][j]; }
#pragma unroll
            for (int j = 0; j < 4; ++j) {
                const float tot = row16_sum(ss[j]); const float rstd = rsqrtf(tot * (1.f / 128.f) + 1e-6f);
                const int i = mt * 16 + fq * 4 + j; const int n = tok_of(s, p0 + i, colorder);
#pragma unroll
                for (int nt = 0; nt < 8; ++nt) { const int col = nt * 16 + fr; const float gate = bf2f(P[(size_t)n * LDP + P_GG + h * 128 + col]);
                    YG[(size_t)n * 512 + h * 128 + col] = f2bf(acc[nt][j] * rstd * p.in[I_GNORM][l * 128 + col] * siluf(gate)); }
            }
        }
    }
}

__device__ __forceinline__ void ph_rw_prep(const PR& p, int l) {
    const bf16_t* P = (const bf16_t*)(p.ws + OFF_ARENA + A_P); bf16_t* RKV = (bf16_t*)(p.ws + OFF_ARENA + A_RKVS); bf16_t* AS = (bf16_t*)(p.ws + OFF_ARENA + A_AS);
    bf16_t* VF = (bf16_t*)(p.ws + OFF_VF); float* kinv = (float*)(p.ws + OFF_KINV);
    const int colorder = (l & 1), tid = otid(), wave = tid >> 6, lane = tid & 63;
    const float* mu = p.in[I_MU] + (size_t)l * 1920; const float* kkw = p.in[I_KK] + (size_t)l * 512;
    for (int n = blockIdx.x * 8 + wave; n < NTOK; n += gridDim.x * 8) {
        int s, pos, T;
        if (n < NLAT) { s = n >> 12; const int t = n & 4095; pos = colorder ? (((t & 63) << 6) | (t >> 6)) : t; T = SEQ; } else { s = 4 + ((n - NLAT) >> 8); pos = (n - NLAT) & 255; T = CTX; }
        const bool hp = pos > 0, hn = pos < T - 1;
        const bf16_t* r0 = P + (size_t)n * LDP; const bf16_t* rp = P + (size_t)(hp ? tok_of(s, pos - 1, colorder) : n) * LDP; const bf16_t* rn = P + (size_t)(hn ? tok_of(s, pos + 1, colorder) : n) * LDP;
        const float wp = hp ? 0.5f : 0.f, wn = hn ? 0.5f : 0.f;
#pragma unroll
        for (int j = 0; j < 15; ++j) {
            const int c = j * 128 + lane * 2;
            const unsigned u0 = *(const unsigned*)(r0 + c), up = *(const unsigned*)(rp + c), un = *(const unsigned*)(rn + c);
            const hf2_t m2 = *(const hf2_t*)(mu + c);
            const float f0 = lo_bf(u0), f1 = hi_bf(u0);
            const float s0 = f0 + m2[0] * (wp * lo_bf(up) + wn * lo_bf(un) - f0), s1 = f1 + m2[1] * (wp * hi_bf(up) + wn * hi_bf(un) - f1);
            if (j < 12) {
                *(unsigned*)(RKV + (size_t)n * 1536 + c) = cvt_pk_bf16(s0, s1);
                if (j >= 4 && j < 8) { const hf2_t k2 = *(const hf2_t*)(kkw + (c - 512)); const float t0 = s0 * k2[0], t1 = s1 * k2[1]; float ss = t0 * t0 + t1 * t1;
#pragma unroll
                    for (int o = 16; o > 0; o >>= 1) ss += __shfl_xor(ss, o);
                    if ((lane & 31) == 0) kinv[(size_t)n * 8 + (j - 4) * 2 + (lane >> 5)] = rsqrtf(ss + 1e-12f); }
                if (j >= 8 && l == 0) *(unsigned*)(VF + (size_t)n * 512 + (c - 1024)) = cvt_pk_bf16(s0, s1);
            } else {
                float o0, o1;
                if (j == 12) { o0 = tanhf(s0); o1 = tanhf(s1); } else if (j == 13) { o0 = s0; o1 = s1; } else { o0 = sigm(s0); o1 = sigm(s1); }
                *(unsigned*)(AS + (size_t)n * 384 + (c - 1536)) = cvt_pk_bf16(o0, o1);
            }
        }
    }
}

constexpr int SC_T = 32;
constexpr int SC_BUF = 4 * SC_T * 64 * 4 + SC_T * 16 * 4 + 4 * 64 * 4;
__device__ __forceinline__ void ph_rw_scan(const PR& p, unsigned char* shm, int l) {
    const bf16_t* RKV = (const bf16_t*)(p.ws + OFF_ARENA + A_RKVS); const bf16_t* LR = (const bf16_t*)(p.ws + OFF_ARENA + A_LR); const float* kinv = (const float*)(p.ws + OFF_KINV);
    float* bon = (float*)(p.ws + OFF_BON); bf16_t* YF = (bf16_t*)(p.ws + OFF_ARENA + A_YF); bf16_t* YB = (bf16_t*)(p.ws + OFF_ARENA + A_YB);
    const int colorder = (l & 1), tid = otid(), lane = tid & 63;
    for (int it = blockIdx.x; it < 256; it += gridDim.x) {
        const int rq = it & 3, d = (it >> 2) & 1, h = (it >> 3) & 7, b = it >> 6;
        bf16_t* Yd = d ? YB : YF;
        __syncthreads();
        const bool loader = tid >= 256;
        const int ch = lane, sg = (tid >> 6) & 3, cidx = h * 64 + ch;
        const float k_k = p.in[I_KK][l * 512 + cidx], k_a = p.in[I_KA][l * 512 + cidx], r_k = p.in[I_RK][l * 512 + cidx];
        const int cw = tid >> 6, rowg = lane >> 4, ks = lane & 15, row = rq * 16 + cw * 4 + rowg;
        hf2_t sA = {0.f, 0.f}, sB = {0.f, 0.f};
        constexpr int NCH = (CTX + SEQ) / SC_T;
        bf16_t rr[8], rk[8], rv[8], rw[8], ra[8]; float rki[8]; int rn[8];
        auto issue = [&](int chunk) {
            const int gs0 = chunk * SC_T + sg * 8;
            int n0; if (gs0 < CTX) n0 = tok_of(4 + b, d ? (CTX - 1 - gs0) : gs0, 0); else { const int qq = gs0 - CTX; n0 = tok_of(b, d ? (SEQ - 1 - qq) : qq, colorder); }
            const int dn = ((gs0 >= CTX) && colorder) ? (d ? -64 : 64) : (d ? -1 : 1);
            const bf16_t* rp0 = RKV + (size_t)n0 * 1536 + cidx; const bf16_t* lp0 = LR + (size_t)n0 * 2048 + d * 512 + cidx; const float* kp0 = kinv + (size_t)n0 * 8 + h;
            const long drp = (long)dn * 1536, dlp = (long)dn * 2048, dkp = (long)dn * 8;
#pragma unroll
            for (int q = 0; q < 8; ++q) {
                rn[q] = n0 + q * dn;
                const bf16_t* rp = rp0 + q * drp; const bf16_t* lp = lp0 + q * dlp;
                rr[q] = rp[0]; rk[q] = rp[512]; rv[q] = rp[1024]; rw[q] = lp[0]; ra[q] = lp[1024]; rki[q] = kp0[q * dkp];
            }
        };
        auto process = [&](int chunk) {
            unsigned char* buf = shm + (chunk & 1) * SC_BUF;
            float* Kr = (float*)buf; float* Kk = Kr + SC_T * 64; float* Ka = Kk + SC_T * 64; float* Rr = Ka + SC_T * 64; float* Vv = Rr + SC_T * 64; float* Dg = Vv + SC_T * 16;
            float P = 0.f, Dprev = 1.f;
#pragma unroll
            for (int q = 0; q < 8; ++q) {
                const int st = sg * 8 + q, n = rn[q];
                const float r = bf2f(rr[q]), k = bf2f(rk[q]), v = bf2f(rv[q]);
                P += bf2f(rw[q]);
                const float D = __expf(-P), iD = __expf(P);
                const float a = bf2f(ra[q]);
                const float krep = k * (1.f + (a - 1.f) * k_a);
                const float kk = k * k_k * rki[q];
                Kr[st * 64 + ch] = krep * iD; Kk[st * 64 + ch] = kk * Dprev; Ka[st * 64 + ch] = kk * a * iD; Rr[st * 64 + ch] = r * D; if ((ch >> 4) == rq) Vv[st * 16 + (ch & 15)] = v;
                Dprev = D;
                if ((q & 3) == rq) {
                    const float bsum = wave_sum(r * krep * r_k);
                    if (ch == 0) bon[((size_t)d * NTOK + n) * 8 + h] = bsum; }
            }
            Dg[sg * 64 + ch] = Dprev;
        };
        auto yreduce = [&](int chunk) {
            const float* yb = (const float*)(shm + 2 * SC_BUF + (chunk & 1) * 32768);
#pragma nounroll
            for (int o2 = 0; o2 < 2; ++o2) {
                const int o = (tid - 256) + o2 * 256, st = o >> 4, rowl = o & 15, gs = chunk * SC_T + st;
                int n;
                if (gs < CTX) n = tok_of(4 + b, d ? (CTX - 1 - gs) : gs, 0); else { const int qq = gs - CTX; n = tok_of(b, d ? (SEQ - 1 - qq) : qq, colorder); }
                const f32x4 y0 = *(const f32x4*)(yb + o * 16), y1 = *(const f32x4*)(yb + o * 16 + 4), y2 = *(const f32x4*)(yb + o * 16 + 8), y3 = *(const f32x4*)(yb + o * 16 + 12);
                const f32x4 ys = (y0 + y1) + (y2 + y3);
                Yd[(size_t)n * 512 + h * 64 + rq * 16 + rowl] = f2bf((ys[0] + ys[1]) + (ys[2] + ys[3]));
            }
        };
        if (loader) { issue(0); process(0); issue(1); }
        __syncthreads();
        for (int c = 0; c < NCH; ++c) {
            if (loader) { if (c + 1 < NCH) { process(c + 1); if (c + 2 < NCH) issue(c + 2); } if (c >= 1) yreduce(c - 1); }
            else {
                const unsigned char* buf = shm + (c & 1) * SC_BUF;
                const float* Kr = (const float*)buf; const float* Kk = Kr + SC_T * 64; const float* Ka = Kk + SC_T * 64; const float* Rr = Ka + SC_T * 64; const float* Vv = Rr + SC_T * 64; const float* Dg = Vv + SC_T * 16;
                f32x4 pkr[3], pkk[3], pka[3], pr[3]; float pv[3];
                f32x4 dgc = {1.f, 1.f, 1.f, 1.f};
                float* ybw = (float*)(shm + 2 * SC_BUF + (c & 1) * 32768) + (cw * 4 + rowg) * 16 + ks;
#define SC_LOAD(slot, st_) do { const int _o = (st_) * 64 + ks * 4; pkr[slot] = *(const f32x4*)(Kr + _o); pkk[slot] = *(const f32x4*)(Kk + _o); \
                    pka[slot] = *(const f32x4*)(Ka + _o); pr[slot] = *(const f32x4*)(Rr + _o); pv[slot] = Vv[(st_) * 16 + cw * 4 + rowg]; } while (0)
                SC_LOAD(0, 0); SC_LOAD(1, 1);
#pragma unroll
                for (int st = 0; st < SC_T; ++st) {
                    const int cs = st % 3, ns = (st + 2) % 3;
                    if (st + 2 < SC_T) SC_LOAD(ns, st + 2);
                    __builtin_amdgcn_sched_barrier(0x6);
                    const f32x4 kr4 = pkr[cs], kk4 = pkk[cs], ka4 = pka[cs], r4 = pr[cs]; const float v = pv[cs];
                    const hf2_t t2 = sA * kk4.lo + sB * kk4.hi;
                    const float sa = row16_sum(t2[0] + t2[1]);
                    const hf2_t vv = {v, v}, nsa = {-sa, -sa};
                    sA = sA + vv * kr4.lo + nsa * ka4.lo;
                    sB = sB + vv * kr4.hi + nsa * ka4.hi;
                    const hf2_t u2 = sA * r4.lo + sB * r4.hi;
                    ybw[st * 256] = u2[0] + u2[1];
                    if ((st & 7) == 4) dgc = *(const f32x4*)(Dg + (st >> 3) * 64 + ks * 4);
                    if ((st & 7) == 7) { sA *= dgc.lo; sB *= dgc.hi; }
                }
#undef SC_LOAD
            }
            __syncthreads();
        }
        if (loader) yreduce(NCH - 1);
    }
}

__device__ __forceinline__ void ph_rw_post(const PR& p, int l, int ntok) {
    bf16_t* YF = (bf16_t*)(p.ws + OFF_ARENA + A_YF); const bf16_t* YB = (const bf16_t*)(p.ws + OFF_ARENA + A_YB); const bf16_t* RKV = (const bf16_t*)(p.ws + OFF_ARENA + A_RKVS);
    const bf16_t* G = (const bf16_t*)(p.ws + OFF_ARENA + A_G); const float* bon = (const float*)(p.ws + OFF_BON);
    const int tid = otid(), wave = tid >> 6, lane = tid & 63, c0 = lane * 8, h = lane >> 3;
    float gw[8], gb[8];
#pragma unroll
    for (int j = 0; j < 8; ++j) { gw[j] = p.in[I_GNW][l * 512 + c0 + j]; gb[j] = p.in[I_GNB][l * 512 + c0 + j]; }
    for (int n = blockIdx.x * 8 + wave; n < ntok; n += gridDim.x * 8) {
        const u32x4 yf = *(const u32x4*)(YF + (size_t)n * 512 + c0), yb = *(const u32x4*)(YB + (size_t)n * 512 + c0), vv = *(const u32x4*)(RKV + (size_t)n * 1536 + 1024 + c0), gg = *(const u32x4*)(G + (size_t)n * 512 + c0);
        const float bs = bon[(size_t)n * 8 + h] + bon[((size_t)NTOK + n) * 8 + h];
        float y[8]; float sum = 0.f;
#pragma unroll
        for (int j = 0; j < 4; ++j) { y[2 * j] = lo_bf(yf[j]) + lo_bf(yb[j]); y[2 * j + 1] = hi_bf(yf[j]) + hi_bf(yb[j]); sum += y[2 * j] + y[2 * j + 1]; }
        sum += __shfl_xor(sum, 1); sum += __shfl_xor(sum, 2); sum += __shfl_xor(sum, 4);
        const float mean = sum * (1.f / 64.f);
        float vs = 0.f;
#pragma unroll
        for (int j = 0; j < 8; ++j) { y[j] -= mean; vs += y[j] * y[j]; }
        vs += __shfl_xor(vs, 1); vs += __shfl_xor(vs, 2); vs += __shfl_xor(vs, 4);
        const float rstd = rsqrtf(vs * (1.f / 64.f) + 64e-5f);
        float o[8];
#pragma unroll
        for (int j = 0; j < 4; ++j) {
            o[2 * j] = (y[2 * j] * rstd * gw[2 * j] + gb[2 * j] + bs * lo_bf(vv[j])) * lo_bf(gg[j]);
            o[2 * j + 1] = (y[2 * j + 1] * rstd * gw[2 * j + 1] + gb[2 * j + 1] + bs * hi_bf(vv[j])) * hi_bf(gg[j]); }
        u32x4 w; w.x = cvt_pk_bf16(o[0], o[1]); w.y = cvt_pk_bf16(o[2], o[3]); w.z = cvt_pk_bf16(o[4], o[5]); w.w = cvt_pk_bf16(o[6], o[7]);
        *(u32x4*)(YF + (size_t)n * 512 + c0) = w;
    }
}


#define XB_TMO      128
#define XB_XCNT(j)  (256  + 64 * (j))
#define XB_XSUB(j)  (1280 + 64 * (j))
#define XB_XGEN(j)  (2304 + 64 * (j))
#define XB_TOP      3328
#define XB_TOPGEN   3392
#define XCD_BAR_WORDS 3456
#define XB_SPIN_CAP (1u << 18)
__device__ __forceinline__ unsigned xb_ld(unsigned* p)              { return __hip_atomic_load(p, __ATOMIC_RELAXED, __HIP_MEMORY_SCOPE_AGENT); }
__device__ __forceinline__ unsigned xb_add(unsigned* p, unsigned v) { return __hip_atomic_fetch_add(p, v, __ATOMIC_RELAXED, __HIP_MEMORY_SCOPE_AGENT); }
__device__ __forceinline__ unsigned xb_xcc_id() { return (unsigned)__builtin_amdgcn_s_getreg((3 << 11) | 20) & 0xFu; }
#define XB_SPIN(cond, bar) do { unsigned _sp = 0; while (cond) { __builtin_amdgcn_s_sleep(1); \
    if ((++_sp & 255u) == 0u) { if (xb_ld(&(bar)[XB_TMO])) break; if (_sp > XB_SPIN_CAP) { atomicAdd(&(bar)[XB_TMO], 1u); break; } } } } while (0)
struct XcdBarrier { unsigned* bar; unsigned x; volatile LAS unsigned* st; };
__device__ __forceinline__ XcdBarrier xcd_barrier_post(unsigned* bar, volatile LAS unsigned* st) {
    XcdBarrier b; b.bar = bar; b.x = xb_xcc_id(); b.st = st;
    if (threadIdx.x == 0) (void)xb_add(&bar[XB_XCNT(b.x)], 1u);
    return b;
}
__device__ __forceinline__ void xcd_barrier_complete(unsigned* bar, unsigned x, unsigned& nloc, unsigned& nx) {
    const unsigned G = gridDim.x * gridDim.y * gridDim.z;
    unsigned sum, cnt, mine, sp = 0u;
    for (;;) {
        sum = 0u; cnt = 0u; mine = 0u;
#pragma unroll
        for (unsigned j = 0; j < 16; ++j) { const unsigned c = xb_ld(&bar[XB_XCNT(j)]); sum += c; cnt += (c > 0u) ? 1u : 0u; mine = (j == x) ? c : mine; }
        if (sum == G) break;
        __builtin_amdgcn_s_sleep(1);
        if ((++sp & 255u) == 0u) { if (xb_ld(&bar[XB_TMO])) break; if (sp > XB_SPIN_CAP) { atomicAdd(&bar[XB_TMO], 1u); break; } }
    }
    nloc = mine > 0u ? mine : 1u; nx = cnt > 0u ? cnt : 1u;
}
__device__ __forceinline__ void xcd_barrier(const XcdBarrier& b) {
    asm volatile("s_waitcnt vmcnt(0)" ::: "memory");
    __syncthreads();
    if (threadIdx.x == 0) {
        unsigned* bar = b.bar;
        __builtin_amdgcn_s_waitcnt(0);
        unsigned nloc = b.st[0], nx = b.st[1];
        if (nloc == 0u) { xcd_barrier_complete(bar, b.x, nloc, nx); b.st[0] = nloc; b.st[1] = nx; }
        const unsigned old = xb_add(&bar[XB_XSUB(b.x)], 1u);
        const unsigned gen = old / nloc;
        if (old + 1u == (gen + 1u) * nloc) {
            __builtin_amdgcn_fence(__ATOMIC_RELEASE, "agent");
            asm volatile("s_waitcnt vmcnt(0)" ::: "memory");
            const unsigned og = xb_add(&bar[XB_TOP], 1u);
            const unsigned tg = og / nx;
            if (og + 1u == (tg + 1u) * nx) xb_add(&bar[XB_TOPGEN], 1u);
            else XB_SPIN(xb_ld(&bar[XB_TOPGEN]) == tg, bar);
            __builtin_amdgcn_fence(__ATOMIC_ACQUIRE, "agent");
            xb_add(&bar[XB_XGEN(b.x)], 1u);
            asm volatile("s_waitcnt vmcnt(0)" ::: "memory");
        } else {
            XB_SPIN(xb_ld(&bar[XB_XGEN(b.x)]) == gen, bar);
            __builtin_amdgcn_fence(__ATOMIC_ACQUIRE, "agent");
            asm volatile("s_waitcnt vmcnt(0)" ::: "memory");
        }
    }
    __syncthreads();
}

constexpr int PH_PER_LAYER = 17, N_PHASES = 2 + 2 * PH_PER_LAYER;
template <int ph> __device__ __forceinline__ void run_phase(const PR& p, unsigned char* shm) {
    unsigned char* ar = p.ws + OFF_ARENA; unsigned char* W = p.ws + OFF_WMIX;
    float* xc = (float*)(p.ws + OFF_XC);
    if (ph == 0) { ph_wconv_mix(p, shm, 0); ph_mod_partial(p, shm); return; }
    if (ph == 1) { ph_mod_reduce(p); return; }
    constexpr int l = (ph - 2) / PH_PER_LAYER, q = (ph - 2) % PH_PER_LAYER;
    const float* mod = (const float*)(p.ws + OFF_MOD) + (size_t)l * 5 * 6144;
    const float* xs_lat = (l == 0) ? p.in[I_X] : p.out; const float* xs_ctx = (l == 0) ? p.in[I_CTX] : xc;
    const int MM = (l == 1) ? NLAT : NTOK;
    switch (q) {
    case 0: if (l == 0) ph_rowwise(xs_lat, xs_ctx, nullptr, nullptr, nullptr, nullptr, 0, p.in[I_NMPRE] + l * DM, 0, 1, (bf16_t*)p.out, mod, mod, NTOK, nullptr, (bf16_t*)xc); break;
    case 1: if (l == 0) {
                run_gemm<E_STORE>(shm, (const bf16_t*)p.out, 1024, (const bf16_t*)(W + W_WIN), 1024, NLAT, LDP, 1024, mk_epi<E_STORE>((bf16_t*)(ar + A_P), LDP));
                run_gemm<E_STORE>(shm, (const bf16_t*)xc, 1024, (const bf16_t*)(W + W_WIN), 1024, NCTX, LDP, 1024, mk_epi<E_STORE>((bf16_t*)(ar + A_P) + (size_t)NLAT * LDP, LDP), 128);
            } else run_gemm<E_STORE>(shm, (const bf16_t*)(ar + A_H), 1024, (const bf16_t*)(W + W_WIN), 1024, NTOK, LDP, 1024, mk_epi<E_STORE>((bf16_t*)(ar + A_P), LDP));
            break;
    case 2: ph_gla_a(p, shm, l); break;
    case 3: ph_gla_b(p); break;
    case 4: ph_gla_c(p, shm, l); break;
    case 5: ph_rw_prep(p, l); break;
    case 6: if (l >= 1) run_gemm<E_STORE>(shm, (const bf16_t*)(ar + A_RKVS) + 1024, 1536, (const bf16_t*)(W + W_VD), 512, NTOK, 256, 512, mk_epi<E_STORE>((bf16_t*)(ar + A_VDB), 256)); break;
    case 7: if (l >= 1) run_gemm<E_VRES>(shm, (const bf16_t*)(ar + A_VDB), 256, (const bf16_t*)(W + W_VU), 256, NTOK, 512, 256,
                                         mk_epi<E_VRES>((bf16_t*)(ar + A_RKVS) + 1024, 1536, (const bf16_t*)(p.ws + OFF_VF), 512, p.in[I_VB] + (size_t)(l - 1) * 512)); break;
    case 8: run_gemm<E_LR>(shm, (const bf16_t*)(ar + A_AS), 384, (const bf16_t*)(W + W_BD), 384, NTOK, 2560, 384, mk_epi<E_LR>((bf16_t*)(ar + A_LR), 2048, (const bf16_t*)(ar + A_G), 512, p.in[I_W0] + (size_t)l * 1024, p.in[I_A0] + (size_t)l * 1024)); break;
    case 9: ph_rw_scan(p, shm, l); break;
    case 10: ph_rw_post(p, l, MM);
             if (l != 0) ph_rowwise(xs_lat, xs_ctx, nullptr, nullptr, nullptr, nullptr, 0, p.in[I_NMPRE] + l * DM, 0, 1, (bf16_t*)(ar + A_HR), mod, mod, MM); break;
    case 11: {
        bf16_t* G1 = (bf16_t*)(ar + A_G1); bf16_t* G2 = (bf16_t*)(ar + A_G2);
        const bf16_t* H = (l == 0) ? (const bf16_t*)p.out : (const bf16_t*)(ar + A_HR);
        run_gemm<E_SIGMOID>(shm, H, 1024, (const bf16_t*)(W + W_GRW), 1024, NLAT, 1024, 1024, mk_epi<E_SIGMOID>(G1, 1024));
        run_gemm<E_MUL>(shm, (const bf16_t*)(ar + A_YF), 512, (const bf16_t*)(W + W_RWO), 512, NLAT, 1024, 512, mk_epi<E_MUL>(G1, 1024));
        run_gemm<E_SIGMOID>(shm, H, 1024, (const bf16_t*)(W + W_GGLA), 1024, NLAT, 1024, 1024, mk_epi<E_SIGMOID>(G2, 1024));
        run_gemm<E_FMA>(shm, (const bf16_t*)(ar + A_YG), 512, (const bf16_t*)(W + W_GLO), 512, NLAT, 1024, 512, mk_epi<E_FMA>(G1, 1024, G2, 1024));
        if (l == 0) {
            const size_t ro = (size_t)NLAT; const bf16_t* Hc = (const bf16_t*)xc;
            run_gemm<E_SIGMOID>(shm, Hc, 1024, (const bf16_t*)(W + W_GRW), 1024, NCTX, 1024, 1024, mk_epi<E_SIGMOID>(G1 + ro * 1024, 1024), 64);
            run_gemm<E_MUL>(shm, (const bf16_t*)(ar + A_YF) + ro * 512, 512, (const bf16_t*)(W + W_RWO), 512, NCTX, 1024, 512, mk_epi<E_MUL>(G1 + ro * 1024, 1024), 64);
            run_gemm<E_SIGMOID>(shm, Hc, 1024, (const bf16_t*)(W + W_GGLA), 1024, NCTX, 1024, 1024, mk_epi<E_SIGMOID>(G2 + ro * 1024, 1024), 64);
            run_gemm<E_FMA>(shm, (const bf16_t*)(ar + A_YG) + ro * 512, 512, (const bf16_t*)(W + W_GLO), 512, NCTX, 1024, 512, mk_epi<E_FMA>(G1 + ro * 1024, 1024, G2 + ro * 1024, 1024), 64);
        }
    } break;
    case 12: run_gemm<E_STORE>(shm, (const bf16_t*)(ar + A_G1), 1024, (const bf16_t*)(W + W_MRG), 1024, NLAT, 1024, 1024, mk_epi<E_STORE>((bf16_t*)(ar + A_M), 1024));
             if (l == 0) {
#pragma unroll
                 for (int sl = 0; sl < 4; ++sl) run_gemm<E_F32>(shm, (const bf16_t*)(ar + A_G1) + (size_t)NLAT * 1024 + sl * 256, 1024, (const bf16_t*)(W + W_MRG) + sl * 256, 1024, NCTX, 1024, 256,
                                                                 mk_epi<E_F32>((bf16_t*)((float*)(ar + A_PART12) + (size_t)sl * NCTX * DM), 1024), 16 * sl + 64); }
             break;
    case 13: ph_rowwise(xs_lat, xs_ctx, p.out, xc, (const bf16_t*)(ar + A_M), p.in[I_NMPOST] + l * DM, 2, p.in[I_NFPRE] + l * DM, 3, 4, (bf16_t*)(ar + A_H2), mod, mod, MM, (const float*)(ar + A_PART12));
             ph_wconv_mlp(p, shm, l); break;
    case 14: run_gemm<E_RELU2>(shm, (const bf16_t*)(ar + A_H2), 1024, (const bf16_t*)(ar + A_WMLP), 1024, MM, 4096, 1024, mk_epi<E_RELU2>((bf16_t*)(ar + A_U), 4096)); break;
    case 15: run_gemm<E_STORE>(shm, (const bf16_t*)(ar + A_U), 4096, (const bf16_t*)(ar + A_WMLP) + (size_t)DFF * DM, 4096, NLAT, 1024, 4096, mk_epi<E_STORE>((bf16_t*)(ar + A_F), 1024));
             if (l == 0) {
#pragma unroll
                 for (int sl = 0; sl < 4; ++sl) run_gemm<E_F32>(shm, (const bf16_t*)(ar + A_U) + (size_t)NLAT * 4096 + sl * 1024, 4096, (const bf16_t*)(ar + A_WMLP) + (size_t)DFF * DM + sl * 1024, 4096, NCTX, 1024, 1024,
                                                                 mk_epi<E_F32>((bf16_t*)((float*)(ar + A_PART15) + (size_t)sl * NCTX * DM), 1024), 16 * sl + 64); }
             break;
    case 16:
        if (l == 0) { const float* mod1 = (const float*)(p.ws + OFF_MOD) + (size_t)5 * 6144;
            ph_rowwise(p.out, xc, p.out, xc, (const bf16_t*)(ar + A_F), p.in[I_NFPOST] + l * DM, 5, p.in[I_NMPRE] + (l + 1) * DM, 0, 1, (bf16_t*)(ar + A_H), mod, mod1, NTOK, (const float*)(ar + A_PART15));
            ph_wconv_mix(p, shm, 1); }
        else ph_rowwise(p.out, xc, p.out, xc, (const bf16_t*)(ar + A_F), p.in[I_NFPOST] + l * DM, 5, nullptr, 0, 0, nullptr, mod, mod, NLAT);
        break;
    }
}

constexpr bool phase_empty(int ph) { return ph >= 2 && ((((ph - 2) / PH_PER_LAYER) == 0 && (((ph - 2) % PH_PER_LAYER) == 6 || ((ph - 2) % PH_PER_LAYER) == 7)) || (((ph - 2) / PH_PER_LAYER) == 1 && ((ph - 2) % PH_PER_LAYER) == 0)); }
template <int ph> __device__ __forceinline__ void phase_seq(const PR& p, unsigned char* shm, int lo, int hi, int coop, const XcdBarrier& xb) {
    if constexpr (ph < N_PHASES) {
        if constexpr (!phase_empty(ph)) {
            if (lo <= ph && ph < hi) {
                run_phase<ph>(p, shm);
                if constexpr (ph >= 2 && ph < 2 + PH_PER_LAYER && ((DBG_REP >> (ph - 2)) & 1)) { if (coop) xcd_barrier(xb); run_phase<ph>(p, shm); }
                if (coop && ph + 1 < hi) xcd_barrier(xb);
            }
        }
        phase_seq<ph + 1>(p, shm, lo, hi, coop, xb);
    }
}
__global__ void __launch_bounds__(NTHREADS, 2) k_mega(PR p, int ph_lo, int ph_hi, int coop) {
    extern __shared__ __attribute__((aligned(16))) unsigned char shm[];
    XcdBarrier xb; xb.bar = nullptr; xb.x = 0; xb.st = (volatile LAS unsigned*)(shm + LDS_BYTES - 16);
    if (coop) {
        if (coop > 1) cg::this_grid().sync();
        if (threadIdx.x == 0) { xb.st[0] = 0u; xb.st[1] = 0u; }
        __syncthreads();
        xb = xcd_barrier_post((unsigned*)(p.ws + OFF_BAR), (volatile LAS unsigned*)(shm + LDS_BYTES - 16));
    }
    phase_seq<0>(p, shm, ph_lo, ph_hi, coop, xb);
}

#if DBG_HI
__global__ void k_dump(PR p, size_t off, int nelem) {
    const bf16_t* src = (const bf16_t*)(p.ws + off);
    for (int i = blockIdx.x * blockDim.x + threadIdx.x; i < NLAT * DM; i += gridDim.x * blockDim.x) p.out[i] = (i < nelem) ? bf2f(src[i]) : 0.f;
}
#endif
extern "C" void kernel_launch(void* const* d_in, const int* in_sizes, int n_in, void* d_out, int out_size, void* d_ws, size_t ws_size, hipStream_t stream) {
    static int grid = 0;
    if (grid == 0) {
        if (n_in != N_IN || ws_size < WS_NEED) { fprintf(stderr, "kernel_launch: unexpected inputs (%d) or workspace (%zu < %zu)\n", n_in, ws_size, (size_t)WS_NEED); grid = -1; return; }
        int dev = 0, cus = 0, per_cu = 0;
        hipGetDevice(&dev); hipDeviceGetAttribute(&cus, hipDeviceAttributeMultiprocessorCount, dev);
        hipFuncSetAttribute((const void*)k_mega, hipFuncAttributeMaxDynamicSharedMemorySize, LDS_BYTES);
        hipOccupancyMaxActiveBlocksPerMultiprocessor(&per_cu, (const void*)k_mega, NTHREADS, LDS_BYTES);
        (void)hipGetLastError();
        if (per_cu < 1) per_cu = 1;
        grid = cus * 1;
        if (grid > 256) grid = 256;
    }
    if (grid < 0) return;
    PR p{};
    for (int i = 0; i < N_IN; ++i) p.in[i] = (const float*)d_in[i];
    p.out = (float*)d_out; p.ws = (unsigned char*)d_ws;
#if MEGA
    if (hipMemsetAsync((char*)d_ws + OFF_BAR, 0, XCD_BAR_WORDS * 4, stream) != hipSuccess) { fprintf(stderr, "kernel_launch: memset of the barrier words failed\n"); return; }
    int lo = 0, hi = N_PHASES, coop = 1;
    void* args[] = {&p, &lo, &hi, &coop};
    hipError_t e = hipLaunchCooperativeKernel((const void*)k_mega, dim3(grid), dim3(NTHREADS), args, LDS_BYTES, stream);
    if (e != hipSuccess) fprintf(stderr, "cooperative launch failed: %s (grid %d)\n", hipGetErrorString(e), grid);
#else
    for (int ph = 0; ph < (DBG_HI ? DBG_HI : N_PHASES); ++ph) {
        const int l = (ph - 2) / PH_PER_LAYER, q = (ph - 2) % PH_PER_LAYER;
        if (ph >= 2 && ((l == 0 && (q == 6 || q == 7)) || (l == 1 && q == 0))) continue;
        hipLaunchKernelGGL(k_mega, dim3(grid), dim3(NTHREADS), LDS_BYTES, stream, p, ph, ph + 1, 0);
    }
#if DBG_HI
#ifdef DBG_OFF
    hipLaunchKernelGGL(k_dump, dim3(1024), dim3(256), 0, stream, p, (size_t)(DBG_OFF), (int)(DBG_N));
#endif
#endif
#endif
}
```

```cpp
#include <hip/hip_runtime.h>
#include <hip/hip_cooperative_groups.h>
#include <cstdio>
namespace cg = cooperative_groups;

#ifndef MEGA
#define MEGA 1
#endif
#ifndef DBG_REP
#define DBG_REP 0
#endif
#ifndef DBG_HI
#define DBG_HI 0
#define DBG_OFF (OFF_ARENA + A_KV)
#define DBG_N (NLAT * DM)
#endif

#define LAS __attribute__((address_space(3)))
typedef unsigned short bf16_t;
typedef short bf16x8 __attribute__((ext_vector_type(8)));
typedef float f32x4 __attribute__((ext_vector_type(4)));
typedef unsigned u32x4 __attribute__((ext_vector_type(4)));
typedef unsigned u32x2 __attribute__((ext_vector_type(2)));

constexpr int DM = 1024, NB = 4, SEQ = 4096, CTX = 256, NLAT = NB * SEQ, NCTX = NB * CTX, NTOK = NLAT + NCTX;
constexpr int INC = 5536, DFF = 4096;
constexpr int LDP = 3584;
constexpr int P_R = 0, P_K = 512, P_V = 1024, P_LRIN = 1536, P_GQ = 1920, P_GK = 2176, P_GV = 2432, P_ALF = 2944, P_ALB = 2960, P_GG = 2976;
constexpr int NTHREADS = 512;
constexpr int LDS_BYTES = 147456;

enum { I_X = 0, I_C, I_CTX, I_CCTX, I_WIN, I_MU, I_W0, I_WUP, I_A0, I_AUP, I_GUP, I_KK, I_KA, I_RK, I_GNW, I_GNB, I_VDN, I_VUP, I_VB, I_RWO, I_CONV, I_ALUP, I_ALB,
       I_GNORM, I_GLO, I_MRG, I_W1, I_W2, I_ADAW, I_ADAB, I_NMPRE, I_NMPOST, I_NFPRE, I_NFPOST, N_IN };

struct PR { const float* in[N_IN]; float* out; unsigned char* ws; };

constexpr size_t UU = (size_t)NTOK * 1024 * 2;
constexpr size_t OFF_XC = 0;
constexpr size_t OFF_VF = OFF_XC + (size_t)NCTX * DM * 4;
constexpr size_t OFF_MOD = OFF_VF + (size_t)NTOK * 512 * 2;
constexpr size_t OFF_MODP = OFF_MOD + 2 * 5 * 6144 * 4;
constexpr size_t OFF_KINV = OFF_MODP + 8 * 2 * 5 * 6144 * 4;
constexpr size_t OFF_BON = OFF_KINV + (size_t)NTOK * 8 * 4;
constexpr size_t OFF_GDEC = OFF_BON + 2 * (size_t)NTOK * 8 * 4;
constexpr size_t OFF_BAR = OFF_GDEC + 2176 * 64 * 4;
constexpr size_t OFF_WMIX = OFF_BAR + 16384;
constexpr size_t W_WIN = 0, W_GRW = W_WIN + (size_t)LDP * 1024 * 2, W_GGLA = W_GRW + 1024 * 1024 * 2, W_RWO = W_GGLA + 1024 * 1024 * 2, W_GLO = W_RWO + 1024 * 512 * 2,
                 W_MRG = W_GLO + 1024 * 512 * 2, W_BD = W_MRG + 1024 * 1024 * 2, W_VD = W_BD + 2560 * 384 * 2, W_VU = W_VD + 256 * 512 * 2, W_MIX_END = W_VU + 512 * 256 * 2;
constexpr size_t OFF_ARENA = OFF_WMIX + W_MIX_END;
constexpr size_t A_P = 0, A_H = UU * 7 / 2, A_YG = UU * 7 / 2, A_KV = UU * 4, A_RKVS = UU * 4, A_AS = UU * 11 / 2, A_VDB = UU * 47 / 8, A_LR = 0, A_G = UU * 2, A_YF = UU * 5 / 2,
                 A_YB = UU * 3, A_HR = 0, A_G1 = UU, A_G2 = UU * 4, A_M = UU * 5, A_H2 = 0, A_WMLP = UU, A_U = UU * 3 / 2, A_F = 0, A_PART12 = UU * 2, A_PART15 = UU * 11 / 2;
constexpr size_t WS_NEED = OFF_ARENA + UU * 49 / 8;

__device__ __forceinline__ int otid() { int t = threadIdx.x; asm volatile("" : "+v"(t)); return t; }
__device__ __forceinline__ float bf2f(bf16_t v) { return __uint_as_float(((unsigned)v) << 16); }
typedef __bf16 hbf2_t __attribute__((ext_vector_type(2)));
typedef float hf2_t __attribute__((ext_vector_type(2)));
__device__ __forceinline__ unsigned cvt_pk_bf16(float lo, float hi) { const hf2_t v = {lo, hi}; return __builtin_bit_cast(unsigned, __builtin_convertvector(v, hbf2_t)); }
__device__ __forceinline__ bf16_t f2bf(float f) { return (bf16_t)(cvt_pk_bf16(f, 0.f) & 0xffffu); }
__device__ __forceinline__ float lo_bf(unsigned u) { return __uint_as_float(u << 16); }
__device__ __forceinline__ float hi_bf(unsigned u) { return __uint_as_float(u & 0xffff0000u); }
__device__ __forceinline__ float sigm(float x) { return __builtin_amdgcn_rcpf(1.f + __expf(-x)); }
__device__ __forceinline__ float siluf(float x) { return x * sigm(x); }
__device__ __forceinline__ float wave_sum(float v) {
#pragma unroll
    for (int o = 32; o > 0; o >>= 1) v += __shfl_xor(v, o);
    return v;
}
template <int CTRL> __device__ __forceinline__ float dppf(float x) { return __int_as_float(__builtin_amdgcn_update_dpp(0, __float_as_int(x), CTRL, 0xf, 0xf, true)); }
__device__ __forceinline__ float row16_sum(float x) {
    x += dppf<0x128>(x); x += dppf<0x124>(x); x += dppf<0x122>(x); x += dppf<0x121>(x); return x;
}
__device__ __forceinline__ int tok_of(int s, int p, int colorder) {
    if (s >= 4) return NLAT + (s - 4) * CTX + p;
    const int t = colorder ? (((p & 63) << 6) | (p >> 6)) : p;
    return s * SEQ + t;
}

namespace pg8 {
constexpr int BM = 256, BK = 64, HALF = 128, HTB = HALF * BK * 2, NXCD = 8, WGM = 8;
__host__ __device__ __forceinline__ int lds_byte(int r, int c) { const int st = (r >> 4) * 2 + (c >> 5), rr = r & 15, cc = c & 31, ob = rr * 64 + cc * 2; return st * 1024 + (ob ^ (((ob >> 9) & 1) << 5)); }
__host__ __device__ __forceinline__ void stage_rc(int b, int& R, int& C) { const int st = b / 1024, sb = b % 1024, swz = sb ^ (((sb >> 9) & 1) << 5); R = (st >> 1) * 16 + swz / 64; C = (st & 1) * 32 + (swz % 64) / 2; }
__host__ __device__ __forceinline__ int perm32(int rho) { const int n = rho >> 4, i = rho & 15; return 8 * (i >> 2) + 4 * n + (i & 3); }
struct Unit { int pm, pn; };
struct Gemm { const bf16_t* A; const bf16_t* Bt; int M, N, K, lda, ldb; };
struct StaticOrder {
    int nM, nN, nwg, G, c;
    __device__ void init(int M, int N, int G_, int c_) { nM = M / BM; nN = N / BM; nwg = nM * nN; G = G_; c = c_; }
    __device__ bool next(int i, Unit& u) const {
        const long L = (long)i * G + c; if (L >= nwg) return false;
        int wgid = (int)L; { const int q = nwg / NXCD, r = nwg % NXCD, xcd = wgid % NXCD, off = wgid / NXCD; wgid = (xcd < r ? xcd * (q + 1) : r * (q + 1) + (xcd - r) * q) + off; }
        const int nig = WGM * nN, gid = wgid / nig, fm = gid * WGM, gsz = (nM - fm) < WGM ? (nM - fm) : WGM;
        u.pm = fm + ((wgid % nig) % gsz); u.pn = (wgid % nig) / gsz; return true;
    }
};

template <class Epi>
__device__ __forceinline__ void gemm_phase(LAS unsigned char* lds, const Gemm g, const StaticOrder& S, const Epi& E) {
    int tid = threadIdx.x; asm volatile("" : "+v"(tid));
    const int wid = __builtin_amdgcn_readfirstlane(tid >> 6), lane = tid & 63, wr = wid >> 2, wc = wid & 3, fr = lane & 15, fq = lane >> 4;
    int K = g.K; asm volatile("" : "+s"(K));
    const int nt = K / BK;
    unsigned voffA[2], voffB[2];
#pragma unroll
    for (int i = 0; i < 2; ++i) { int R, C; stage_rc(tid * 16 + i * 8192, R, C); const int Rb = (R & ~31) + perm32(R & 31);
        voffA[i] = (unsigned)(R * g.lda + C) * 2u; voffB[i] = (unsigned)(Rb * g.ldb + C) * 2u; }
    const size_t kstep = (size_t)(BK * 2);
    const size_t hstepA = (size_t)HALF * g.lda * 2, hstepB = (size_t)HALF * g.ldb * 2;
    const size_t tstepA = 2 * hstepA, tstepB = 2 * hstepB;
    const unsigned ldsw = (unsigned)wid * 1024u;
    const int aoff = lds_byte(wr * 64 + fr, fq * 8), boff = lds_byte(wc * 32 + fr, fq * 8);
#define PG8_SA(b, h) (((b) * 2 + (h)) * HTB)
#define PG8_SB(b, h) ((4 + (b) * 2 + (h)) * HTB)
#define PG8_STAGE(bufoff, gbase, voff) do { _Pragma("unroll") for (int _i = 0; _i < 2; ++_i) \
        __builtin_amdgcn_global_load_lds((const unsigned*)((const char*)(gbase) + (voff)[_i]), (LAS unsigned*)(lds + (bufoff) + ldsw + _i * 8192), 16, 0, 0); } while (0)
#define PG8_LDA(dst, b, h) do { _Pragma("unroll") for (int m = 0; m < 4; ++m) _Pragma("unroll") for (int k = 0; k < 2; ++k) dst[m][k] = *(const LAS bf16x8*)(lds + PG8_SA(b, h) + aoff + m * 2048 + k * 1024); } while (0)
#define PG8_LDB(dst, b, h) do { _Pragma("unroll") for (int n = 0; n < 2; ++n) _Pragma("unroll") for (int k = 0; k < 2; ++k) dst[n][k] = *(const LAS bf16x8*)(lds + PG8_SB(b, h) + boff + n * 2048 + k * 1024); } while (0)
#define PG8_MMA(ai, bj, At, Bt) do { __builtin_amdgcn_s_setprio(1); _Pragma("unroll") for (int m = 0; m < 4; ++m) _Pragma("unroll") for (int n = 0; n < 2; ++n) _Pragma("unroll") for (int k = 0; k < 2; ++k) \
        acc[ai][bj][m][n] = __builtin_amdgcn_mfma_f32_16x16x32_bf16(Bt[n][k], At[m][k], acc[ai][bj][m][n], 0, 0, 0); __builtin_amdgcn_s_setprio(0); } while (0)
#define PG8_WAIT_V(n) asm volatile("s_waitcnt vmcnt(" #n ")" ::: "memory")
#define PG8_WAIT_L(n) asm volatile("s_waitcnt lgkmcnt(" #n ")" ::: "memory")
#define PG8_BAR __builtin_amdgcn_s_barrier()
#define PG8_SCHED __builtin_amdgcn_sched_barrier(0)
    Unit cur, nxt; int ui = 0;
    if (!S.next(0, cur)) return;
    f32x4 acc[2][2][4][2];
#pragma unroll
    for (int a = 0; a < 2; ++a)
#pragma unroll
        for (int b = 0; b < 2; ++b)
#pragma unroll
            for (int m = 0; m < 4; ++m)
#pragma unroll
                for (int n = 0; n < 2; ++n) acc[a][b][m][n] = (f32x4){0.f, 0.f, 0.f, 0.f};
    bf16x8 At[4][2], B0[2][2], B1[2][2];
    const char* cA = (const char*)g.A + (size_t)cur.pm * tstepA; const char* cB = (const char*)g.Bt + (size_t)cur.pn * tstepB;
    PG8_STAGE(PG8_SB(0, 0), cB, voffB); PG8_STAGE(PG8_SA(0, 0), cA, voffA); PG8_STAGE(PG8_SB(0, 1), cB + hstepB, voffB); PG8_STAGE(PG8_SA(0, 1), cA + hstepA, voffA);
    if (wr == 1) PG8_BAR;
    PG8_WAIT_V(4); PG8_BAR;
    PG8_STAGE(PG8_SB(1, 0), cB + kstep, voffB); PG8_STAGE(PG8_SA(1, 0), cA + kstep, voffA); PG8_STAGE(PG8_SB(1, 1), cB + hstepB + kstep, voffB);
    PG8_WAIT_V(6); PG8_BAR;
    for (;;) {
        const bool has_next = S.next(ui + 1, nxt);
        const char* nA = has_next ? (const char*)g.A + (size_t)nxt.pm * tstepA : cA; const char* nB = has_next ? (const char*)g.Bt + (size_t)nxt.pn * tstepB : cB;
#pragma nounroll
        for (int t = 0; t < nt; t += 2) {
            const bool last = (t == nt - 2);
            const char* a1 = cA + (size_t)(t + 1) * kstep;
            const char* a2 = last ? nA : cA + (size_t)(t + 2) * kstep; const char* b2 = last ? nB : cB + (size_t)(t + 2) * kstep;
            const char* a3 = a2 + kstep; const char* b3 = b2 + kstep;
            PG8_LDB(B0, 0, 0); PG8_SCHED; PG8_LDA(At, 0, 0); PG8_STAGE(PG8_SA(1, 1), a1 + hstepA, voffA);
            PG8_WAIT_L(8); PG8_BAR; PG8_WAIT_L(0); PG8_MMA(0, 0, At, B0); PG8_BAR; PG8_SCHED;
            PG8_LDB(B1, 0, 1); PG8_STAGE(PG8_SB(0, 0), b2, voffB);
            PG8_BAR; PG8_WAIT_L(0); PG8_MMA(0, 1, At, B1); PG8_BAR;
            PG8_LDA(At, 0, 1); PG8_STAGE(PG8_SA(0, 0), a2, voffA);
            PG8_BAR; PG8_WAIT_L(0); PG8_MMA(1, 0, At, B0); PG8_BAR; PG8_SCHED;
            PG8_STAGE(PG8_SB(0, 1), b2 + hstepB, voffB);
            PG8_WAIT_V(6); PG8_BAR; PG8_MMA(1, 1, At, B1); PG8_BAR;
            PG8_LDB(B0, 1, 0); PG8_SCHED; PG8_LDA(At, 1, 0); PG8_STAGE(PG8_SA(0, 1), a2 + hstepA, voffA);
            PG8_WAIT_L(8); PG8_BAR; PG8_WAIT_L(0); PG8_MMA(0, 0, At, B0); PG8_BAR; PG8_SCHED;
            PG8_LDB(B1, 1, 1); PG8_STAGE(PG8_SB(1, 0), b3, voffB);
            PG8_BAR; PG8_WAIT_L(0); PG8_MMA(0, 1, At, B1); PG8_BAR;
            PG8_LDA(At, 1, 1); PG8_STAGE(PG8_SA(1, 0), a3, voffA);
            PG8_BAR; PG8_WAIT_L(0); PG8_MMA(1, 0, At, B0); PG8_BAR; PG8_SCHED;
            PG8_STAGE(PG8_SB(1, 1), b3 + hstepB, voffB);
            PG8_WAIT_V(6); PG8_BAR; PG8_MMA(1, 1, At, B1); PG8_BAR;
        }
        E(acc, cur, wr, wc, fr, fq);
        if (!has_next) break;
#pragma unroll
        for (int a = 0; a < 2; ++a)
#pragma unroll
            for (int b = 0; b < 2; ++b)
#pragma unroll
                for (int m = 0; m < 4; ++m)
#pragma unroll
                    for (int n = 0; n < 2; ++n) acc[a][b][m][n] = (f32x4){0.f, 0.f, 0.f, 0.f};
        cur = nxt; cA = nA; cB = nB; ++ui;
    }
    PG8_WAIT_V(0);
    if (wr == 0) PG8_BAR;
    PG8_BAR;
#undef PG8_SA
#undef PG8_SB
#undef PG8_STAGE
#undef PG8_LDA
#undef PG8_LDB
#undef PG8_MMA
#undef PG8_WAIT_V
#undef PG8_WAIT_L
#undef PG8_BAR
#undef PG8_SCHED
}
}

enum { E_STORE = 0, E_SIGMOID, E_MUL, E_FMA, E_RELU2, E_VRES, E_LR, E_F32 };
template <int MODE> struct Epi {
    bf16_t* d0; int ld0;
    const bf16_t* aux; int ldaux; const float* bias; const float* bias2;
    __device__ __forceinline__ void operator()(const f32x4 (&acc)[2][2][4][2], const pg8::Unit& u, int wr, int wc, int fr, int fq) const {
        const int row0 = u.pm * 256 + wr * 64 + fr; const int colt = u.pn * 256; bf16_t* base = d0; const int ld = ld0;
        const int col0 = colt + wc * 32 + 8 * fq;
#pragma unroll
        for (int ai = 0; ai < 2; ++ai)
#pragma unroll
            for (int m = 0; m < 4; ++m) {
                const int row = row0 + ai * 128 + m * 16;
#pragma unroll
                for (int bj = 0; bj < 2; ++bj) {
                    const int c = col0 + bj * 128;
                    if (MODE == E_F32) {
                        float* fp = (float*)d0 + (size_t)row * ld + c; *(f32x4*)fp = acc[ai][bj][m][0]; *(f32x4*)(fp + 4) = acc[ai][bj][m][1];
                        continue;
                    }
                    if (MODE == E_VRES) {
#pragma unroll
                        for (int hh = 0; hh < 2; ++hh) {
                            bf16_t* p4 = base + (size_t)row * ld + c + 4 * hh;
                            const u32x2 o = *(const u32x2*)p4; const u32x2 g = *(const u32x2*)(aux + (size_t)row * ldaux + c + 4 * hh); const f32x4 bb = *(const f32x4*)(bias + c + 4 * hh);
                            const f32x4 a4 = acc[ai][bj][m][hh];
                            float r4[4];
#pragma unroll
                            for (int j = 0; j < 2; ++j) {
                                const float v0 = __uint_as_float(o[j] << 16), v1 = __uint_as_float(o[j] & 0xffff0000u), f0 = __uint_as_float(g[j] << 16), f1 = __uint_as_float(g[j] & 0xffff0000u);
                                r4[2 * j] = v0 + (f0 - v0) * sigm(bb[2 * j] + a4[2 * j]); r4[2 * j + 1] = v1 + (f1 - v1) * sigm(bb[2 * j + 1] + a4[2 * j + 1]); }
                            u32x2 w2; w2[0] = cvt_pk_bf16(r4[0], r4[1]); w2[1] = cvt_pk_bf16(r4[2], r4[3]);
                            *(u32x2*)p4 = w2;
                            __builtin_amdgcn_sched_barrier(0);
                        }
                        continue;
                    }
                    float v[8];
#pragma unroll
                    for (int j = 0; j < 4; ++j) { v[j] = acc[ai][bj][m][0][j]; v[4 + j] = acc[ai][bj][m][1][j]; }
                    bf16_t* ptr = base + (size_t)row * ld + c;
                    if (MODE == E_LR && colt >= 2048) {
                        ptr = (bf16_t*)aux + (size_t)row * ldaux + (c - 2048);
                    } else if (MODE == E_LR) {
                        const float* bp = (colt < 1024) ? bias + c : bias2 + (c - 1024);
                        const f32x4 b0 = *(const f32x4*)bp, b1 = *(const f32x4*)(bp + 4);
#pragma unroll
                        for (int j = 0; j < 4; ++j) { v[j] += b0[j]; v[4 + j] += b1[j]; }
                        if (colt < 1024) {
#pragma unroll
                            for (int j = 0; j < 8; ++j) { const float sp = fmaxf(-v[j], 0.f) + __logf(1.f + __expf(-fabsf(v[j]))); v[j] = __expf(-sp - 0.5f); }
                        } else {
#pragma unroll
                            for (int j = 0; j < 8; ++j) v[j] = sigm(v[j]);
                        }
                    } else if (MODE == E_SIGMOID) {
#pragma unroll
                        for (int j = 0; j < 8; ++j) v[j] = sigm(v[j]);
                    } else if (MODE == E_RELU2) {
#pragma unroll
                        for (int j = 0; j < 8; ++j) { const float t = fmaxf(v[j], 0.f); v[j] = t * t; }
                    } else if (MODE == E_MUL) {
                        const u32x4 o = *(const u32x4*)ptr;
#pragma unroll
                        for (int j = 0; j < 4; ++j) { v[2 * j] *= __uint_as_float(o[j] << 16); v[2 * j + 1] *= __uint_as_float(o[j] & 0xffff0000u); }
                    } else if (MODE == E_FMA) {
                        const u32x4 o = *(const u32x4*)ptr; const u32x4 g = *(const u32x4*)(aux + (size_t)row * ldaux + c);
#pragma unroll
                        for (int j = 0; j < 4; ++j) { v[2 * j] = __uint_as_float(o[j] << 16) + __uint_as_float(g[j] << 16) * v[2 * j];
                            v[2 * j + 1] = __uint_as_float(o[j] & 0xffff0000u) + __uint_as_float(g[j] & 0xffff0000u) * v[2 * j + 1]; }
                    }
                    u32x4 w; w.x = cvt_pk_bf16(v[0], v[1]); w.y = cvt_pk_bf16(v[2], v[3]); w.z = cvt_pk_bf16(v[4], v[5]); w.w = cvt_pk_bf16(v[6], v[7]);
                    *(u32x4*)ptr = w;
                    if (MODE >= E_MUL) __builtin_amdgcn_sched_barrier(0);
                }
            }
    }
};
template <int MODE>
__device__ __forceinline__ void run_gemm(unsigned char* shm, const bf16_t* A, int lda, const bf16_t* Bt, int ldb, int M, int N, int K, const Epi<MODE>& E, int coff = 0) {
    pg8::Gemm g; g.A = A; g.Bt = Bt; g.M = M; g.N = N; g.K = K; g.lda = lda; g.ldb = ldb;
    pg8::StaticOrder S; S.init(M, N, (int)gridDim.x, (int)((blockIdx.x + gridDim.x - coff) % gridDim.x));
    pg8::gemm_phase<Epi<MODE>>((LAS unsigned char*)shm, g, S, E);
}
template <int MODE> __device__ __forceinline__ Epi<MODE> mk_epi(bf16_t* d0, int ld0, const bf16_t* aux = nullptr, int ldaux = 0, const float* bias = nullptr, const float* bias2 = nullptr) {
    Epi<MODE> e; e.bias2 = bias2; e.d0 = d0; e.ld0 = ld0; e.aux = aux; e.ldaux = ldaux; e.bias = bias; return e;
}

__device__ __forceinline__ int tconv_tiles(int K, int nrows) { return (K / 64) * (nrows / 64); }
__device__ __forceinline__ void tconv_tile(unsigned char* shm, const float* src, int sld, int c0, int K, int ncols, int nrows, bf16_t* dst, int ldd, int tile) {
    float* t = (float*)shm;
    const int nkt = K / 64, ti = tile % nkt, tj = tile / nkt;
    const int tid = otid();
    __syncthreads();
#pragma unroll
    for (int r = 0; r < 2; ++r) { const int e = tid + r * NTHREADS, i = e >> 4, c4 = e & 15, j = tj * 64 + c4 * 4;
        f32x4 v = {0.f, 0.f, 0.f, 0.f};
        if (j < ncols) v = *(const f32x4*)(src + (size_t)(ti * 64 + i) * sld + c0 + j);
        t[i * 65 + c4 * 4] = v[0]; t[i * 65 + c4 * 4 + 1] = v[1]; t[i * 65 + c4 * 4 + 2] = v[2]; t[i * 65 + c4 * 4 + 3] = v[3]; }
    __syncthreads();
    { const int jl = tid >> 3, ko = tid & 7;
        float f[8];
#pragma unroll
        for (int m = 0; m < 8; ++m) f[m] = t[(ko * 8 + m) * 65 + jl];
        u32x4 w; w.x = cvt_pk_bf16(f[0], f[1]); w.y = cvt_pk_bf16(f[2], f[3]); w.z = cvt_pk_bf16(f[4], f[5]); w.w = cvt_pk_bf16(f[6], f[7]);
        *(u32x4*)(dst + (size_t)(tj * 64 + jl) * ldd + ti * 64 + ko * 8) = w; }
}
__device__ __forceinline__ void ph_wconv_mix(const PR& p, unsigned char* shm, int l) {
    unsigned char* W = p.ws + OFF_WMIX;
    const float* win = p.in[I_WIN] + (size_t)l * DM * INC;
    const int n0 = tconv_tiles(1024, LDP), n1 = n0 + tconv_tiles(1024, 1024), n2 = n1 + tconv_tiles(1024, 1024), n3 = n2 + tconv_tiles(512, 1024), n4 = n3 + tconv_tiles(512, 1024), n5 = n4 + tconv_tiles(1024, 1024);
    for (int it = blockIdx.x; it < n5; it += gridDim.x) {
        if (it < n0) tconv_tile(shm, win, INC, 0, 1024, 3488, LDP, (bf16_t*)(W + W_WIN), 1024, it);
        else if (it < n1) tconv_tile(shm, win, INC, 3488, 1024, 1024, 1024, (bf16_t*)(W + W_GRW), 1024, it - n0);
        else if (it < n2) tconv_tile(shm, win, INC, 4512, 1024, 1024, 1024, (bf16_t*)(W + W_GGLA), 1024, it - n1);
        else if (it < n3) tconv_tile(shm, p.in[I_RWO] + (size_t)l * 512 * 1024, 1024, 0, 512, 1024, 1024, (bf16_t*)(W + W_RWO), 512, it - n2);
        else if (it < n4) tconv_tile(shm, p.in[I_GLO] + (size_t)l * 512 * 1024, 1024, 0, 512, 1024, 1024, (bf16_t*)(W + W_GLO), 512, it - n3);
        else tconv_tile(shm, p.in[I_MRG] + (size_t)l * 1024 * 1024, 1024, 0, 1024, 1024, 1024, (bf16_t*)(W + W_MRG), 1024, it - n4);
    }
    const size_t gt = (size_t)blockIdx.x * NTHREADS + otid(), gs = (size_t)gridDim.x * NTHREADS;
    bf16_t* bd = (bf16_t*)(W + W_BD);
    for (size_t e = gt; e < (size_t)2560 * 384; e += gs) {
        const int row = (int)(e / 384), k = (int)(e % 384); float v = 0.f;
        if (row < 2048) { const int blk = row >> 9, j = row & 511; if ((k >> 6) == blk) { const int kk = k & 63;
                const float* src = (blk < 2) ? p.in[I_WUP] + ((size_t)(l * 2 + blk) * 64) * 512 : p.in[I_AUP] + ((size_t)(l * 2 + (blk - 2)) * 64) * 512; v = src[(size_t)kk * 512 + j]; } }
        else { const int j = row - 2048; if (k >= 256) v = p.in[I_GUP][((size_t)l * 128 + (k - 256)) * 512 + j]; }
        bd[e] = f2bf(v);
    }
    if (l >= 1) {
        bf16_t* vd = (bf16_t*)(W + W_VD); bf16_t* vu = (bf16_t*)(W + W_VU);
        const float* dn = p.in[I_VDN] + (size_t)(l - 1) * 512 * 32; const float* up = p.in[I_VUP] + (size_t)(l - 1) * 32 * 512;
        for (size_t e = gt; e < (size_t)256 * 512; e += gs) { const int row = (int)(e / 512), k = (int)(e % 512); vd[e] = f2bf(row < 32 ? dn[(size_t)k * 32 + row] : 0.f); }
        for (size_t e = gt; e < (size_t)512 * 256; e += gs) { const int row = (int)(e / 256), k = (int)(e % 256); vu[e] = f2bf(k < 32 ? up[(size_t)k * 512 + row] : 0.f); }
    }
}
__device__ __forceinline__ void ph_wconv_mlp(const PR& p, unsigned char* shm, int l) {
    bf16_t* w1 = (bf16_t*)(p.ws + OFF_ARENA + A_WMLP); bf16_t* w2 = w1 + (size_t)DFF * DM;
    const int n0 = tconv_tiles(1024, 4096), n1 = n0 + tconv_tiles(4096, 1024);
    for (int it = blockIdx.x; it < n1; it += gridDim.x) {
        if (it < n0) tconv_tile(shm, p.in[I_W1] + (size_t)l * DM * DFF, DFF, 0, 1024, 4096, 4096, w1, 1024, it);
        else tconv_tile(shm, p.in[I_W2] + (size_t)l * DFF * DM, DM, 0, 4096, 1024, 1024, w2, 4096, it - n0);
    }
}

__device__ __forceinline__ void ph_mod_partial(const PR& p, unsigned char* shm) {
    float* sc = (float*)shm;
    float* modp = (float*)(p.ws + OFF_MODP);
    for (int it = blockIdx.x; it < 2 * 12 * 8; it += gridDim.x) {
        const int ks = it & 7, cb = (it >> 3) % 12, l = it / 96;
        __syncthreads();
        for (int e = otid(); e < 5 * 128; e += NTHREADS) { const int j = e >> 7, k = ks * 128 + (e & 127); const float cv = (j < 4) ? p.in[I_C][j * 1024 + k] : p.in[I_CCTX][k]; sc[e] = siluf(cv); }
        __syncthreads();
        const int col = cb * 512 + otid();
        const float* w = p.in[I_ADAW] + ((size_t)l * 1024 + ks * 128) * 6144 + col;
        float a0 = 0, a1 = 0, a2 = 0, a3 = 0, a4 = 0;
#pragma unroll 8
        for (int k = 0; k < 128; ++k) { const float wv = w[(size_t)k * 6144]; a0 += sc[k] * wv; a1 += sc[128 + k] * wv; a2 += sc[256 + k] * wv; a3 += sc[384 + k] * wv; a4 += sc[512 + k] * wv; }
        float* o = modp + ((size_t)(ks * 2 + l) * 5) * 6144 + col;
        o[0] = a0; o[6144] = a1; o[2 * 6144] = a2; o[3 * 6144] = a3; o[4 * 6144] = a4;
    }
}
__device__ __forceinline__ void ph_mod_reduce(const PR& p) {
    const float* modp = (const float*)(p.ws + OFF_MODP); float* mod = (float*)(p.ws + OFF_MOD);
    for (int e = blockIdx.x * NTHREADS + otid(); e < 2 * 5 * 6144; e += gridDim.x * NTHREADS) {
        const int l = e / (5 * 6144), col = e % 6144; float a = p.in[I_ADAB][l * 6144 + col];
#pragma unroll
        for (int ks = 0; ks < 8; ++ks) a += modp[(size_t)ks * 2 * 5 * 6144 + e];
        mod[e] = a;
    }
}

__device__ __forceinline__ void ph_rowwise(const float* xs_lat, const float* xs_ctx, float* xd_lat, float* xd_ctx, const bf16_t* Y, const float* norm_post, int gate_idx,
                           const float* norm_pre, int shift_idx, int scale_idx, bf16_t* Hout, const float* mod, const float* mod_pre, int nrows, const float* Ypart = nullptr, bf16_t* Hctx = nullptr) {
    const int wave = otid() >> 6, lane = otid() & 63;
    auto load_row = [&](int n, float (&x)[16], float (&y)[16]) {
        const float* xs = (n < NLAT) ? xs_lat + (size_t)n * DM : xs_ctx + (size_t)(n - NLAT) * DM;
#pragma unroll
        for (int i = 0; i < 4; ++i) { const f32x4 t = *(const f32x4*)(xs + i * 256 + lane * 4); x[4 * i] = t[0]; x[4 * i + 1] = t[1]; x[4 * i + 2] = t[2]; x[4 * i + 3] = t[3]; }
        if (Y) {
            if (Ypart && n >= NLAT) {
#pragma unroll
                for (int i = 0; i < 4; ++i) { f32x4 a = {0.f, 0.f, 0.f, 0.f};
#pragma unroll
                    for (int sl = 0; sl < 4; ++sl) a += *(const f32x4*)(Ypart + ((size_t)sl * NCTX + (n - NLAT)) * DM + i * 256 + lane * 4);
                    y[4 * i] = a[0]; y[4 * i + 1] = a[1]; y[4 * i + 2] = a[2]; y[4 * i + 3] = a[3]; }
            } else {
#pragma unroll
                for (int i = 0; i < 4; ++i) { const u32x2 t = *(const u32x2*)(Y + (size_t)n * DM + i * 256 + lane * 4);
                    y[4 * i] = lo_bf(t[0]); y[4 * i + 1] = hi_bf(t[0]); y[4 * i + 2] = lo_bf(t[1]); y[4 * i + 3] = hi_bf(t[1]); }
            }
        }
    };
    auto finish_row = [&](int n, float (&x)[16], float (&y)[16]) {
        const float* md = mod + (size_t)((n < NLAT) ? (n >> 12) : 4) * 6144;
        const float* mdp = mod_pre + (size_t)((n < NLAT) ? (n >> 12) : 4) * 6144;
        if (Y) {
            float ss = 0.f;
#pragma unroll
            for (int i = 0; i < 16; ++i) ss += y[i] * y[i];
            ss = wave_sum(ss);
            const float rstd = rsqrtf(ss * (1.f / 1024.f) + 1e-6f);
            float* xd = (n < NLAT) ? xd_lat + (size_t)n * DM : xd_ctx + (size_t)(n - NLAT) * DM;
#pragma unroll
            for (int i = 0; i < 4; ++i) { const int c = i * 256 + lane * 4; const f32x4 np = *(const f32x4*)(norm_post + c); const f32x4 gt = *(const f32x4*)(md + gate_idx * 1024 + c);
                f32x4 o;
#pragma unroll
                for (int j = 0; j < 4; ++j) { x[4 * i + j] += gt[j] * (y[4 * i + j] * rstd * np[j]); o[j] = x[4 * i + j]; }
                *(f32x4*)(xd + c) = o; }
        }
        if (Hout) {
            float ss = 0.f;
#pragma unroll
            for (int i = 0; i < 16; ++i) ss += x[i] * x[i];
            ss = wave_sum(ss);
            const float rstd = rsqrtf(ss * (1.f / 1024.f) + 1e-6f);
#pragma unroll
            for (int i = 0; i < 4; ++i) { const int c = i * 256 + lane * 4; const f32x4 np = *(const f32x4*)(norm_pre + c); const f32x4 sh = *(const f32x4*)(mdp + shift_idx * 1024 + c); const f32x4 sc = *(const f32x4*)(mdp + scale_idx * 1024 + c);
                float h[4];
#pragma unroll
                for (int j = 0; j < 4; ++j) h[j] = x[4 * i + j] * rstd * np[j] * (1.f + sc[j]) + sh[j];
                u32x2 o; o[0] = cvt_pk_bf16(h[0], h[1]); o[1] = cvt_pk_bf16(h[2], h[3]);
                bf16_t* hp = (Hctx && n >= NLAT) ? Hctx + (size_t)(n - NLAT) * DM : Hout + (size_t)n * DM;
                *(u32x2*)(hp + c) = o; }
        }
    };
    const int stride = gridDim.x * 8;
    for (int n = blockIdx.x * 8 + wave; n < nrows; n += 2 * stride) {
        const int n1 = n + stride; const bool has1 = n1 < nrows;
        float xa[16], ya[16], xb[16], yb[16];
        load_row(n, xa, ya); if (has1) load_row(n1, xb, yb);
        finish_row(n, xa, ya); if (has1) finish_row(n1, xb, yb);
    }
}

constexpr int GS = 72;
constexpr int L_QDF = 0, L_QDB = 9216, L_KIF = 18432, L_KIB = 27648, L_VT = 36864, L_KEF = 55296, L_KEB = 64512, L_STF = 73728, L_STB = 92160, L_CUMF = 73728, L_CUMB = 90112, L_ALD = 106496, L_OX = 0;
constexpr int L_RAW = 110592, L_TOT = 144384;
struct GlaRaw { u32x4 v[5]; u32x4 a; };
__device__ __forceinline__ void gla_issue(const PR& p, int l, int cid, int h, GlaRaw& g) {
    const bf16_t* P = (const bf16_t*)(p.ws + OFF_ARENA + A_P);
    const int colorder = !(l & 1);
    const int s = (cid < 256) ? (cid >> 6) : 4 + ((cid - 256) >> 2), nch = (cid < 256) ? (cid & 63) : ((cid - 256) & 3), T = (s < 4) ? SEQ : CTX, p0 = nch * 64;
    const int tid = otid();
#pragma unroll
    for (int k = 0; k < 5; ++k) {
        const int e = tid + k * NTHREADS;
        const int r = e >> 5, c16 = e & 31, pp = p0 - 1 + r, ch0 = c16 * 8;
        const int col = (ch0 < 64) ? (P_GQ + h * 64 + ch0) : (ch0 < 128) ? (P_GK + h * 64 + (ch0 - 64)) : (P_GV + h * 128 + (ch0 - 128));
        u32x4 v = {0u, 0u, 0u, 0u};
        if (e < 66 * 32 && pp >= 0 && pp < T) v = *(const u32x4*)(P + (size_t)tok_of(s, pp, colorder) * LDP + col);
        g.v[k] = v;
    }
    g.a = (u32x4){0u, 0u, 0u, 0u};
    if (tid < 256) { const int r = tid >> 2, c = tid & 3; g.a = *(const u32x4*)(P + (size_t)tok_of(s, p0 + r, colorder) * LDP + P_ALF + c * 8); }
}
__device__ __forceinline__ void gla_stage(const PR& p, unsigned char* shm, int l, int cid, int h, bool need_qd, const GlaRaw& g) {
    const bf16_t* P = (const bf16_t*)(p.ws + OFF_ARENA + A_P);
    const int colorder = !(l & 1);
    const int s = (cid < 256) ? (cid >> 6) : 4 + ((cid - 256) >> 2), nch = (cid < 256) ? (cid & 63) : ((cid - 256) & 3), T = (s < 4) ? SEQ : CTX, p0 = nch * 64;
    const int tid = otid();
    float* cumF = (float*)(shm + L_CUMF); float* cumB = (float*)(shm + L_CUMB); const bf16_t* ald = (const bf16_t*)(shm + L_ALD); float* tot = (float*)(shm + L_TOT);
    const bf16_t* raw = (const bf16_t*)(shm + L_RAW);
    __syncthreads();
#pragma unroll
    for (int k = 0; k < 5; ++k) { const int e = tid + k * NTHREADS; if (e < 66 * 32) *(u32x4*)(shm + L_RAW + ((e >> 5) * 256 + (e & 31) * 8) * 2) = g.v[k]; }
    if (tid < 256) *(u32x4*)(shm + L_ALD + ((tid >> 2) * 32 + (tid & 3) * 8) * 2) = g.a;
    __syncthreads();
    const int key = tid & 63, d = (tid >> 6) & 1, tg = tid >> 7;
    float la[16];
    {
        const float* up = p.in[I_ALUP] + ((size_t)(l * 2 + d) * 16) * 256 + h * 64 + key; const float bias = p.in[I_ALB][(l * 2 + d) * 256 + h * 64 + key];
        typedef __bf16 hbf8_t __attribute__((ext_vector_type(8)));
        hbf2_t wp[8];
#pragma unroll
        for (int k = 0; k < 8; ++k) { const hf2_t w2 = {up[(size_t)(2 * k) * 256], up[(size_t)(2 * k + 1) * 256]}; wp[k] = __builtin_convertvector(w2, hbf2_t); }
#pragma unroll
        for (int i = 0; i < 16; ++i) {
            const hbf8_t x0 = *(const hbf8_t*)(ald + (tg * 16 + i) * 32 + d * 16), x1 = *(const hbf8_t*)(ald + (tg * 16 + i) * 32 + d * 16 + 8);
            float a = bias;
            a = __builtin_amdgcn_fdot2_f32_bf16(__builtin_shufflevector(x0, x0, 0, 1), wp[0], a, false);
            a = __builtin_amdgcn_fdot2_f32_bf16(__builtin_shufflevector(x0, x0, 2, 3), wp[1], a, false);
            a = __builtin_amdgcn_fdot2_f32_bf16(__builtin_shufflevector(x0, x0, 4, 5), wp[2], a, false);
            a = __builtin_amdgcn_fdot2_f32_bf16(__builtin_shufflevector(x0, x0, 6, 7), wp[3], a, false);
            a = __builtin_amdgcn_fdot2_f32_bf16(__builtin_shufflevector(x1, x1, 0, 1), wp[4], a, false);
            a = __builtin_amdgcn_fdot2_f32_bf16(__builtin_shufflevector(x1, x1, 2, 3), wp[5], a, false);
            a = __builtin_amdgcn_fdot2_f32_bf16(__builtin_shufflevector(x1, x1, 4, 5), wp[6], a, false);
            a = __builtin_amdgcn_fdot2_f32_bf16(__builtin_shufflevector(x1, x1, 6, 7), wp[7], a, false);
            la[i] = -(fmaxf(-a, 0.f) + __logf(1.f + __expf(-fabsf(a)))) * (1.f / 16.f);
        }
        if (d == 0) {
#pragma unroll
            for (int i = 1; i < 16; ++i) la[i] += la[i - 1];
            tot[(0 * 4 + tg) * 64 + key] = la[15];
        } else {
#pragma unroll
            for (int i = 14; i >= 0; --i) la[i] += la[i + 1];
            tot[(1 * 4 + tg) * 64 + key] = la[0];
        }
    }
    __syncthreads();
    {
        float off = 0.f;
#pragma unroll
        for (int g = 0; g < 4; ++g) { const float t = tot[(d * 4 + g) * 64 + key]; off += (d == 0 ? (g < tg) : (g > tg)) ? t : 0.f; }
        float* dst = d ? cumB : cumF;
#pragma unroll
        for (int i = 0; i < 16; ++i) dst[(tg * 16 + i) * 64 + key] = la[i] + off;
    }
    __syncthreads();
    {
        const int ch = tid & 255, th = tid >> 8;
        const int cc = (ch < 64) ? (h * 64 + ch) : (ch < 128) ? (256 + h * 64 + (ch - 64)) : (512 + h * 128 + (ch - 128));
        const float* cw = p.in[I_CONV] + (size_t)l * 3 * 1024; const float w0 = cw[cc], w1 = cw[1024 + cc], w2 = cw[2048 + cc];
        const int i0 = th * 32;
        float fm = bf2f(raw[(i0) * 256 + ch]), f0 = bf2f(raw[(i0 + 1) * 256 + ch]);
        bf16_t* qdF = (bf16_t*)(shm + L_QDF); bf16_t* qdB = (bf16_t*)(shm + L_QDB); bf16_t* kiF = (bf16_t*)(shm + L_KIF); bf16_t* kiB = (bf16_t*)(shm + L_KIB);
        bf16_t* vT = (bf16_t*)(shm + L_VT); bf16_t* keF = (bf16_t*)(shm + L_KEF); bf16_t* keB = (bf16_t*)(shm + L_KEB);
        const float totF = (ch >= 64 && ch < 128) ? cumF[63 * 64 + (ch - 64)] : 0.f, totB = (ch >= 64 && ch < 128) ? cumB[ch - 64] : 0.f;
#pragma unroll 4
        for (int i = i0; i < i0 + 32; ++i) {
            const float fp = bf2f(raw[(i + 2) * 256 + ch]);
            const float y = siluf(w0 * fm + w1 * f0 + w2 * fp);
            fm = f0; f0 = fp;
            if (ch < 64) { if (need_qd) { const float q = y * 0.125f; qdF[i * GS + ch] = f2bf(q * __expf(cumF[i * 64 + ch])); qdB[i * GS + ch] = f2bf(q * __expf(cumB[i * 64 + ch])); } }
            else if (ch < 128) { const int kx = ch - 64; const float cf = cumF[i * 64 + kx], cb = cumB[i * 64 + kx];
                if (need_qd) { kiF[i * GS + kx] = f2bf(y * __expf(-cf)); kiB[i * GS + kx] = f2bf(y * __expf(-cb)); }
                else { keF[kx * GS + i] = f2bf(y * __expf(totF - cf)); keB[kx * GS + i] = f2bf(y * __expf(totB - cb)); } }
            else vT[(ch - 128) * GS + i] = f2bf(y);
        }
    }
    __syncthreads();
}
__device__ __forceinline__ bf16x8 lds_frag(const unsigned char* shm, int off, int row, int col) { return *(const bf16x8*)(shm + off + (row * GS + col) * 2); }

__device__ __forceinline__ void ph_gla_a(const PR& p, unsigned char* shm, int l) {
    bf16_t* KV = (bf16_t*)(p.ws + OFF_ARENA + A_KV); float* gdec = (float*)(p.ws + OFF_GDEC);
    const int wave = otid() >> 6, lane = otid() & 63, fr = lane & 15, fq = lane >> 4;
    GlaRaw graw; if (blockIdx.x < 272 * 4) gla_issue(p, l, blockIdx.x >> 2, blockIdx.x & 3, graw);
    for (int it = blockIdx.x; it < 272 * 4; it += gridDim.x) {
        const int cid = it >> 2, h = it & 3;
        gla_stage(p, shm, l, cid, h, false, graw);
        { const int itn = it + gridDim.x; if (itn < 272 * 4) gla_issue(p, l, itn >> 2, itn & 3, graw); }
        const bf16x8 a0 = lds_frag(shm, L_VT, wave * 16 + fr, fq * 8), a1 = lds_frag(shm, L_VT, wave * 16 + fr, 32 + fq * 8);
#pragma unroll
        for (int d = 0; d < 2; ++d)
#pragma unroll
            for (int nt = 0; nt < 4; ++nt) {
                const int off = d ? L_KEB : L_KEF;
                const bf16x8 b0 = lds_frag(shm, off, nt * 16 + fr, fq * 8), b1 = lds_frag(shm, off, nt * 16 + fr, 32 + fq * 8);
                f32x4 c = {0.f, 0.f, 0.f, 0.f};
                c = __builtin_amdgcn_mfma_f32_16x16x32_bf16(a0, b0, c, 0, 0, 0);
                c = __builtin_amdgcn_mfma_f32_16x16x32_bf16(a1, b1, c, 0, 0, 0);
                bf16_t* o = KV + ((size_t)(it * 2 + d) * 128) * 64;
#pragma unroll
                for (int j = 0; j < 4; ++j) o[(wave * 16 + fq * 4 + j) * 64 + nt * 16 + fr] = f2bf(c[j]);
            }
        if (otid() < 128) { const int d = otid() >> 6, key = otid() & 63; const float* cum = (const float*)(shm + (d ? L_CUMB : L_CUMF));
            gdec[(size_t)(it * 2 + d) * 64 + key] = __expf(d ? cum[key] : cum[63 * 64 + key]); }
    }
}
__device__ __forceinline__ void ph_gla_b(const PR& p) {
    unsigned* KV = (unsigned*)(p.ws + OFF_ARENA + A_KV); const float* gdec = (const float*)(p.ws + OFF_GDEC);
    for (int e = blockIdx.x * NTHREADS + otid(); e < 32 * 4096; e += gridDim.x * NTHREADS) {
        const int combo = e >> 12, pe = e & 4095;
        const int b = combo >> 3, h = (combo >> 1) & 3, d = combo & 1, key = (pe & 31) * 2;
        float s0 = 0.f, s1 = 0.f;
#pragma unroll
        for (int hb = 0; hb < 2; ++hb) {
            unsigned kv[34]; float d0[34], d1[34]; unsigned* ptr[34];
#pragma unroll
            for (int j = 0; j < 34; ++j) {
                const int i = hb * 34 + j;
                int cid; if (i < 4) cid = 256 + b * 4 + (d ? 3 - i : i); else cid = b * 64 + (d ? 63 - (i - 4) : (i - 4));
                const size_t ent = (size_t)((cid * 4 + h) * 2 + d);
                ptr[j] = KV + ent * 4096 + pe; kv[j] = *ptr[j]; d0[j] = gdec[ent * 64 + key]; d1[j] = gdec[ent * 64 + key + 1];
            }
#pragma unroll
            for (int j = 0; j < 34; ++j) {
                *ptr[j] = cvt_pk_bf16(s0, s1);
                s0 = s0 * d0[j] + lo_bf(kv[j]); s1 = s1 * d1[j] + hi_bf(kv[j]);
            }
        }
    }
}
__device__ __forceinline__ void ph_gla_c(const PR& p, unsigned char* shm, int l) {
    const bf16_t* P = (const bf16_t*)(p.ws + OFF_ARENA + A_P); const bf16_t* KV = (const bf16_t*)(p.ws + OFF_ARENA + A_KV); bf16_t* YG = (bf16_t*)(p.ws + OFF_ARENA + A_YG);
    const int colorder = !(l & 1);
    const int wave = otid() >> 6, lane = otid() & 63, fr = lane & 15, fq = lane >> 4;
    GlaRaw graw; if (blockIdx.x < 272 * 4) gla_issue(p, l, blockIdx.x >> 2, blockIdx.x & 3, graw);
    for (int it = blockIdx.x; it < 272 * 4; it += gridDim.x) {
        const int cid = it >> 2, h = it & 3;
        const int s = (cid < 256) ? (cid >> 6) : 4 + ((cid - 256) >> 2), nch = (cid < 256) ? (cid & 63) : ((cid - 256) & 3), p0 = nch * 64;
        gla_stage(p, shm, l, cid, h, true, graw);
        { const int itn = it + gridDim.x; if (itn < 272 * 4) gla_issue(p, l, itn >> 2, itn & 3, graw); }
        for (int e = otid(); e < 2 * 128 * 8; e += NTHREADS) { const int d = e >> 10, r = (e >> 3) & 127, c8 = e & 7;
            const u32x4 v = *(const u32x4*)(KV + ((size_t)(it * 2 + d) * 128 + r) * 64 + c8 * 8);
            *(u32x4*)(shm + (d ? L_STB : L_STF) + (r * GS + c8 * 8) * 2) = v; }
        {
            const int d = wave >> 2, mt = wave & 3; const int qoff = d ? L_QDB : L_QDF, koff = d ? L_KIB : L_KIF, poff = d ? L_KEB : L_KEF;
            const bf16x8 a0 = lds_frag(shm, qoff, mt * 16 + fr, fq * 8), a1 = lds_frag(shm, qoff, mt * 16 + fr, 32 + fq * 8);
            bf16_t* Pm = (bf16_t*)(shm + poff);
#pragma unroll
            for (int nt = 0; nt < 4; ++nt) {
                const bf16x8 b0 = lds_frag(shm, koff, nt * 16 + fr, fq * 8), b1 = lds_frag(shm, koff, nt * 16 + fr, 32 + fq * 8);
                f32x4 c = {0.f, 0.f, 0.f, 0.f};
                c = __builtin_amdgcn_mfma_f32_16x16x32_bf16(a0, b0, c, 0, 0, 0);
                c = __builtin_amdgcn_mfma_f32_16x16x32_bf16(a1, b1, c, 0, 0, 0);
#pragma unroll
                for (int j = 0; j < 4; ++j) { const int i = mt * 16 + fq * 4 + j, jj = nt * 16 + fr; const bool keep = d ? (jj >= i) : (jj <= i); Pm[i * GS + jj] = f2bf(keep ? c[j] : 0.f); }
            }
        }
        __syncthreads();
        f32x4 acc[8];
        {
            const int d = wave >> 2, mt = wave & 3; const int qoff = d ? L_QDB : L_QDF, poff = d ? L_KEB : L_KEF, soff = d ? L_STB : L_STF;
            const bf16x8 pa0 = lds_frag(shm, poff, mt * 16 + fr, fq * 8), pa1 = lds_frag(shm, poff, mt * 16 + fr, 32 + fq * 8);
            const bf16x8 qa0 = lds_frag(shm, qoff, mt * 16 + fr, fq * 8), qa1 = lds_frag(shm, qoff, mt * 16 + fr, 32 + fq * 8);
#pragma unroll
            for (int nt = 0; nt < 8; ++nt) {
                f32x4 c = {0.f, 0.f, 0.f, 0.f};
                c = __builtin_amdgcn_mfma_f32_16x16x32_bf16(pa0, lds_frag(shm, L_VT, nt * 16 + fr, fq * 8), c, 0, 0, 0);
                c = __builtin_amdgcn_mfma_f32_16x16x32_bf16(pa1, lds_frag(shm, L_VT, nt * 16 + fr, 32 + fq * 8), c, 0, 0, 0);
                c = __builtin_amdgcn_mfma_f32_16x16x32_bf16(qa0, lds_frag(shm, soff, nt * 16 + fr, fq * 8), c, 0, 0, 0);
                c = __builtin_amdgcn_mfma_f32_16x16x32_bf16(qa1, lds_frag(shm, soff, nt * 16 + fr, 32 + fq * 8), c, 0, 0, 0);
                acc[nt] = c;
            }
        }
        __syncthreads();
        float* ox = (float*)(shm + L_OX);
        if (wave >= 4) { const int mt = wave & 3;
#pragma unroll
            for (int nt = 0; nt < 8; ++nt)
#pragma unroll
                for (int j = 0; j < 4; ++j) ox[(mt * 16 + fq * 4 + j) * 128 + nt * 16 + fr] = acc[nt][j]; }
        __syncthreads();
        if (wave < 4) { const int mt = wave;
            float ss[4] = {0.f, 0.f, 0.f, 0.f};
#pragma unroll
            for (int nt = 0; nt < 8; ++nt)
#pragma unroll
                for (int j = 0; j < 4; ++j) { acc[nt][j] += ox[(mt * 16 + fq * 4 + j) * 128 + nt * 16 + fr]; ss[j] += acc[nt][j] * acc[nt][j]; }
#pragma unroll
            for (int j = 0; j < 4; ++j) {
                const float tot = row16_sum(ss[j]); const float rstd = rsqrtf(tot * (1.f / 128.f) + 1e-6f);
                const int i = mt * 16 + fq * 4 + j; const int n = tok_of(s, p0 + i, colorder);
#pragma unroll
                for (int nt = 0; nt < 8; ++nt) { const int col = nt * 16 + fr; const float gate = bf2f(P[(size_t)n * LDP + P_GG + h * 128 + col]);
                    YG[(size_t)n * 512 + h * 128 + col] = f2bf(acc[nt][j] * rstd * p.in[I_GNORM][l * 128 + col] * siluf(gate)); }
            }
        }
    }
}

__device__ __forceinline__ void ph_rw_prep(const PR& p, int l) {
    const bf16_t* P = (const bf16_t*)(p.ws + OFF_ARENA + A_P); bf16_t* RKV = (bf16_t*)(p.ws + OFF_ARENA + A_RKVS); bf16_t* AS = (bf16_t*)(p.ws + OFF_ARENA + A_AS);
    bf16_t* VF = (bf16_t*)(p.ws + OFF_VF); float* kinv = (float*)(p.ws + OFF_KINV);
    const int colorder = (l & 1), tid = otid(), wave = tid >> 6, lane = tid & 63;
    const float* mu = p.in[I_MU] + (size_t)l * 1920; const float* kkw = p.in[I_KK] + (size_t)l * 512;
    for (int n = blockIdx.x * 8 + wave; n < NTOK; n += gridDim.x * 8) {
        int s, pos, T;
        if (n < NLAT) { s = n >> 12; const int t = n & 4095; pos = colorder ? (((t & 63) << 6) | (t >> 6)) : t; T = SEQ; } else { s = 4 + ((n - NLAT) >> 8); pos = (n - NLAT) & 255; T = CTX; }
        const bool hp = pos > 0, hn = pos < T - 1;
        const bf16_t* r0 = P + (size_t)n * LDP; const bf16_t* rp = P + (size_t)(hp ? tok_of(s, pos - 1, colorder) : n) * LDP; const bf16_t* rn = P + (size_t)(hn ? tok_of(s, pos + 1, colorder) : n) * LDP;
        const float wp = hp ? 0.5f : 0.f, wn = hn ? 0.5f : 0.f;
#pragma unroll
        for (int j = 0; j < 15; ++j) {
            const int c = j * 128 + lane * 2;
            const unsigned u0 = *(const unsigned*)(r0 + c), up = *(const unsigned*)(rp + c), un = *(const unsigned*)(rn + c);
            const hf2_t m2 = *(const hf2_t*)(mu + c);
            const float f0 = lo_bf(u0), f1 = hi_bf(u0);
            const float s0 = f0 + m2[0] * (wp * lo_bf(up) + wn * lo_bf(un) - f0), s1 = f1 + m2[1] * (wp * hi_bf(up) + wn * hi_bf(un) - f1);
            if (j < 12) {
                *(unsigned*)(RKV + (size_t)n * 1536 + c) = cvt_pk_bf16(s0, s1);
                if (j >= 4 && j < 8) { const hf2_t k2 = *(const hf2_t*)(kkw + (c - 512)); const float t0 = s0 * k2[0], t1 = s1 * k2[1]; float ss = t0 * t0 + t1 * t1;
#pragma unroll
                    for (int o = 16; o > 0; o >>= 1) ss += __shfl_xor(ss, o);
                    if ((lane & 31) == 0) kinv[(size_t)n * 8 + (j - 4) * 2 + (lane >> 5)] = rsqrtf(ss + 1e-12f); }
                if (j >= 8 && l == 0) *(unsigned*)(VF + (size_t)n * 512 + (c - 1024)) = cvt_pk_bf16(s0, s1);
            } else {
                float o0, o1;
                if (j == 12) { o0 = tanhf(s0); o1 = tanhf(s1); } else if (j == 13) { o0 = s0; o1 = s1; } else { o0 = sigm(s0); o1 = sigm(s1); }
                *(unsigned*)(AS + (size_t)n * 384 + (c - 1536)) = cvt_pk_bf16(o0, o1);
            }
        }
    }
}

constexpr int SC_T = 32;
constexpr int SC_BUF = 5 * SC_T * 64 * 4 + 4 * 64 * 4;
__device__ __forceinline__ void ph_rw_scan(const PR& p, unsigned char* shm, int l) {
    const bf16_t* RKV = (const bf16_t*)(p.ws + OFF_ARENA + A_RKVS); const bf16_t* LR = (const bf16_t*)(p.ws + OFF_ARENA + A_LR); const float* kinv = (const float*)(p.ws + OFF_KINV);
    float* bon = (float*)(p.ws + OFF_BON); bf16_t* YF = (bf16_t*)(p.ws + OFF_ARENA + A_YF); bf16_t* YB = (bf16_t*)(p.ws + OFF_ARENA + A_YB);
    const int colorder = (l & 1), tid = otid(), lane = tid & 63;
    for (int it = blockIdx.x; it < 256; it += gridDim.x) {
        const int rq = it & 3, d = (it >> 2) & 1, h = (it >> 3) & 7, b = it >> 6;
        bf16_t* Yd = d ? YB : YF;
        __syncthreads();
        const bool loader = tid >= 256;
        const int ch = lane, sg = (tid >> 6) & 3, cidx = h * 64 + ch;
        const float k_k = p.in[I_KK][l * 512 + cidx], k_a = p.in[I_KA][l * 512 + cidx], r_k = p.in[I_RK][l * 512 + cidx];
        const int cw = tid >> 6, rowg = lane >> 4, ks = lane & 15, row = rq * 16 + cw * 4 + rowg;
        hf2_t sA = {0.f, 0.f}, sB = {0.f, 0.f};
        constexpr int NCH = (CTX + SEQ) / SC_T;
        bf16_t rr[8], rk[8], rv[8], rw[8], ra[8]; float rki[8]; int rn[8];
        auto issue = [&](int chunk) {
            const int gs0 = chunk * SC_T + sg * 8;
            int n0; if (gs0 < CTX) n0 = tok_of(4 + b, d ? (CTX - 1 - gs0) : gs0, 0); else { const int qq = gs0 - CTX; n0 = tok_of(b, d ? (SEQ - 1 - qq) : qq, colorder); }
            const int dn = ((gs0 >= CTX) && colorder) ? (d ? -64 : 64) : (d ? -1 : 1);
            const bf16_t* rp0 = RKV + (size_t)n0 * 1536 + cidx; const bf16_t* lp0 = LR + (size_t)n0 * 2048 + d * 512 + cidx; const float* kp0 = kinv + (size_t)n0 * 8 + h;
            const long drp = (long)dn * 1536, dlp = (long)dn * 2048, dkp = (long)dn * 8;
#pragma unroll
            for (int q = 0; q < 8; ++q) {
                rn[q] = n0 + q * dn;
                const bf16_t* rp = rp0 + q * drp; const bf16_t* lp = lp0 + q * dlp;
                rr[q] = rp[0]; rk[q] = rp[512]; rv[q] = rp[1024]; rw[q] = lp[0]; ra[q] = lp[1024]; rki[q] = kp0[q * dkp];
            }
        };
        auto process = [&](int chunk) {
            unsigned char* buf = shm + (chunk & 1) * SC_BUF;
            float* Kr = (float*)buf; float* Kk = Kr + SC_T * 64; float* Ka = Kk + SC_T * 64; float* Rr = Ka + SC_T * 64; float* Vv = Rr + SC_T * 64; float* Dg = Vv + SC_T * 64;
            float P = 0.f, Dprev = 1.f;
#pragma unroll
            for (int q = 0; q < 8; ++q) {
                const int st = sg * 8 + q, n = rn[q];
                const float r = bf2f(rr[q]), k = bf2f(rk[q]), v = bf2f(rv[q]);
                P += bf2f(rw[q]);
                const float D = __expf(-P), iD = __expf(P);
                const float a = bf2f(ra[q]);
                const float krep = k * (1.f + (a - 1.f) * k_a);
                const float kk = k * k_k * rki[q];
                Kr[st * 64 + ch] = krep * iD; Kk[st * 64 + ch] = kk * Dprev; Ka[st * 64 + ch] = kk * a * iD; Rr[st * 64 + ch] = r * D; Vv[st * 64 + ch] = v;
                Dprev = D;
                if ((q & 3) == rq) {
                    const float bsum = wave_sum(r * krep * r_k);
                    if (ch == 0) bon[((size_t)d * NTOK + n) * 8 + h] = bsum; }
            }
            Dg[sg * 64 + ch] = Dprev;
        };
        auto yreduce = [&](int chunk) {
            const float* yb = (const float*)(shm + 2 * SC_BUF + (chunk & 1) * 16384);
#pragma unroll
            for (int o2 = 0; o2 < 2; ++o2) {
                const int o = (tid - 256) + o2 * 256, st = o >> 4, rowl = o & 15, gs = chunk * SC_T + st;
                int n;
                if (gs < CTX) n = tok_of(4 + b, d ? (CTX - 1 - gs) : gs, 0); else { const int qq = gs - CTX; n = tok_of(b, d ? (SEQ - 1 - qq) : qq, colorder); }
                const f32x4 y0 = *(const f32x4*)(yb + o * 8), y1 = *(const f32x4*)(yb + o * 8 + 4);
                const float y = ((y0[0] + y0[1]) + (y0[2] + y0[3])) + ((y1[0] + y1[1]) + (y1[2] + y1[3]));
                Yd[(size_t)n * 512 + h * 64 + rq * 16 + rowl] = f2bf(y);
            }
        };
        if (loader) { issue(0); process(0); issue(1); }
        __syncthreads();
        for (int c = 0; c < NCH; ++c) {
            if (loader) { if (c + 1 < NCH) { process(c + 1); if (c + 2 < NCH) issue(c + 2); } if (c >= 1) yreduce(c - 1); }
            else {
                const unsigned char* buf = shm + (c & 1) * SC_BUF;
                const float* Kr = (const float*)buf; const float* Kk = Kr + SC_T * 64; const float* Ka = Kk + SC_T * 64; const float* Rr = Ka + SC_T * 64; const float* Vv = Rr + SC_T * 64; const float* Dg = Vv + SC_T * 64;
                f32x4 pkr[3], pkk[3], pka[3], pr[3]; float pv[3];
                f32x4 dg[4];
#pragma unroll
                for (int g = 0; g < 4; ++g) dg[g] = *(const f32x4*)(Dg + g * 64 + ks * 4);
                float* ybw = (float*)(shm + 2 * SC_BUF + (c & 1) * 16384) + (cw * 4 + rowg) * 8 + (ks & 7);
#define SC_LOAD(slot, st_) do { const int _o = (st_) * 64 + ks * 4; pkr[slot] = *(const f32x4*)(Kr + _o); pkk[slot] = *(const f32x4*)(Kk + _o); \
                    pka[slot] = *(const f32x4*)(Ka + _o); pr[slot] = *(const f32x4*)(Rr + _o); pv[slot] = Vv[(st_) * 64 + row]; } while (0)
                SC_LOAD(0, 0); SC_LOAD(1, 1);
#pragma unroll
                for (int st = 0; st < SC_T; ++st) {
                    const int cs = st % 3, ns = (st + 2) % 3;
                    if (st + 2 < SC_T) SC_LOAD(ns, st + 2);
                    __builtin_amdgcn_sched_barrier(0x6);
                    const f32x4 kr4 = pkr[cs], kk4 = pkk[cs], ka4 = pka[cs], r4 = pr[cs]; const float v = pv[cs];
                    const hf2_t t2 = sA * kk4.lo + sB * kk4.hi;
                    const float sa = row16_sum(t2[0] + t2[1]);
                    const hf2_t vv = {v, v}, nsa = {-sa, -sa};
                    sA = sA + vv * kr4.lo + nsa * ka4.lo;
                    sB = sB + vv * kr4.hi + nsa * ka4.hi;
                    const hf2_t u2 = sA * r4.lo + sB * r4.hi;
                    float yp = u2[0] + u2[1]; yp += dppf<0x128>(yp);
                    ybw[st * 128] = yp;
                    if ((st & 7) == 7) { sA *= dg[st >> 3].lo; sB *= dg[st >> 3].hi; }
                }
#undef SC_LOAD
            }
            __syncthreads();
        }
        if (loader) yreduce(NCH - 1);
    }
}

__device__ __forceinline__ void ph_rw_post(const PR& p, int l, int ntok) {
    bf16_t* YF = (bf16_t*)(p.ws + OFF_ARENA + A_YF); const bf16_t* YB = (const bf16_t*)(p.ws + OFF_ARENA + A_YB); const bf16_t* RKV = (const bf16_t*)(p.ws + OFF_ARENA + A_RKVS);
    const bf16_t* G = (const bf16_t*)(p.ws + OFF_ARENA + A_G); const float* bon = (const float*)(p.ws + OFF_BON);
    const int tid = otid(), wave = tid >> 6, lane = tid & 63, c0 = lane * 8, h = lane >> 3;
    float gw[8], gb[8];
#pragma unroll
    for (int j = 0; j < 8; ++j) { gw[j] = p.in[I_GNW][l * 512 + c0 + j]; gb[j] = p.in[I_GNB][l * 512 + c0 + j]; }
    for (int n = blockIdx.x * 8 + wave; n < ntok; n += gridDim.x * 8) {
        const u32x4 yf = *(const u32x4*)(YF + (size_t)n * 512 + c0), yb = *(const u32x4*)(YB + (size_t)n * 512 + c0), vv = *(const u32x4*)(RKV + (size_t)n * 1536 + 1024 + c0), gg = *(const u32x4*)(G + (size_t)n * 512 + c0);
        const float bs = bon[(size_t)n * 8 + h] + bon[((size_t)NTOK + n) * 8 + h];
        float y[8]; float sum = 0.f;
#pragma unroll
        for (int j = 0; j < 4; ++j) { y[2 * j] = lo_bf(yf[j]) + lo_bf(yb[j]); y[2 * j + 1] = hi_bf(yf[j]) + hi_bf(yb[j]); sum += y[2 * j] + y[2 * j + 1]; }
        sum += __shfl_xor(sum, 1); sum += __shfl_xor(sum, 2); sum += __shfl_xor(sum, 4);
        const float mean = sum * (1.f / 64.f);
        float vs = 0.f;
#pragma unroll
        for (int j = 0; j < 8; ++j) { y[j] -= mean; vs += y[j] * y[j]; }
        vs += __shfl_xor(vs, 1); vs += __shfl_xor(vs, 2); vs += __shfl_xor(vs, 4);
        const float rstd = rsqrtf(vs * (1.f / 64.f) + 64e-5f);
        float o[8];
#pragma unroll
        for (int j = 0; j < 4; ++j) {
            o[2 * j] = (y[2 * j] * rstd * gw[2 * j] + gb[2 * j] + bs * lo_bf(vv[j])) * lo_bf(gg[j]);
            o[2 * j + 1] = (y[2 * j + 1] * rstd * gw[2 * j + 1] + gb[2 * j + 1] + bs * hi_bf(vv[j])) * hi_bf(gg[j]); }
        u32x4 w; w.x = cvt_pk_bf16(o[0], o[1]); w.y = cvt_pk_bf16(o[2], o[3]); w.z = cvt_pk_bf16(o[4], o[5]); w.w = cvt_pk_bf16(o[6], o[7]);
        *(u32x4*)(YF + (size_t)n * 512 + c0) = w;
    }
}


#define XB_TMO      128
#define XB_XCNT(j)  (256  + 64 * (j))
#define XB_XSUB(j)  (1280 + 64 * (j))
#define XB_XGEN(j)  (2304 + 64 * (j))
#define XB_TOP      3328
#define XB_TOPGEN   3392
#define XCD_BAR_WORDS 3456
#define XB_SPIN_CAP (1u << 18)
__device__ __forceinline__ unsigned xb_ld(unsigned* p)              { return __hip_atomic_load(p, __ATOMIC_RELAXED, __HIP_MEMORY_SCOPE_AGENT); }
__device__ __forceinline__ unsigned xb_add(unsigned* p, unsigned v) { return __hip_atomic_fetch_add(p, v, __ATOMIC_RELAXED, __HIP_MEMORY_SCOPE_AGENT); }
__device__ __forceinline__ unsigned xb_xcc_id() { return (unsigned)__builtin_amdgcn_s_getreg((3 << 11) | 20) & 0xFu; }
#define XB_SPIN(cond, bar) do { unsigned _sp = 0; while (cond) { __builtin_amdgcn_s_sleep(1); \
    if ((++_sp & 255u) == 0u) { if (xb_ld(&(bar)[XB_TMO])) break; if (_sp > XB_SPIN_CAP) { atomicAdd(&(bar)[XB_TMO], 1u); break; } } } } while (0)
struct XcdBarrier { unsigned* bar; unsigned x; volatile LAS unsigned* st; };
__device__ __forceinline__ XcdBarrier xcd_barrier_post(unsigned* bar, volatile LAS unsigned* st) {
    XcdBarrier b; b.bar = bar; b.x = xb_xcc_id(); b.st = st;
    if (threadIdx.x == 0) (void)xb_add(&bar[XB_XCNT(b.x)], 1u);
    return b;
}
__device__ __forceinline__ void xcd_barrier_complete(unsigned* bar, unsigned x, unsigned& nloc, unsigned& nx) {
    const unsigned G = gridDim.x * gridDim.y * gridDim.z;
    unsigned sum, cnt, mine, sp = 0u;
    for (;;) {
        sum = 0u; cnt = 0u; mine = 0u;
#pragma unroll
        for (unsigned j = 0; j < 16; ++j) { const unsigned c = xb_ld(&bar[XB_XCNT(j)]); sum += c; cnt += (c > 0u) ? 1u : 0u; mine = (j == x) ? c : mine; }
        if (sum == G) break;
        __builtin_amdgcn_s_sleep(1);
        if ((++sp & 255u) == 0u) { if (xb_ld(&bar[XB_TMO])) break; if (sp > XB_SPIN_CAP) { atomicAdd(&bar[XB_TMO], 1u); break; } }
    }
    nloc = mine > 0u ? mine : 1u; nx = cnt > 0u ? cnt : 1u;
}
__device__ __forceinline__ void xcd_barrier(const XcdBarrier& b) {
    asm volatile("s_waitcnt vmcnt(0)" ::: "memory");
    __syncthreads();
    if (threadIdx.x == 0) {
        unsigned* bar = b.bar;
        __builtin_amdgcn_s_waitcnt(0);
        unsigned nloc = b.st[0], nx = b.st[1];
        if (nloc == 0u) { xcd_barrier_complete(bar, b.x, nloc, nx); b.st[0] = nloc; b.st[1] = nx; }
        const unsigned old = xb_add(&bar[XB_XSUB(b.x)], 1u);
        const unsigned gen = old / nloc;
        if (old + 1u == (gen + 1u) * nloc) {
            __builtin_amdgcn_fence(__ATOMIC_RELEASE, "agent");
            asm volatile("s_waitcnt vmcnt(0)" ::: "memory");
            const unsigned og = xb_add(&bar[XB_TOP], 1u);
            const unsigned tg = og / nx;
            if (og + 1u == (tg + 1u) * nx) xb_add(&bar[XB_TOPGEN], 1u);
            else XB_SPIN(xb_ld(&bar[XB_TOPGEN]) == tg, bar);
            __builtin_amdgcn_fence(__ATOMIC_ACQUIRE, "agent");
            xb_add(&bar[XB_XGEN(b.x)], 1u);
            asm volatile("s_waitcnt vmcnt(0)" ::: "memory");
        } else {
            XB_SPIN(xb_ld(&bar[XB_XGEN(b.x)]) == gen, bar);
            __builtin_amdgcn_fence(__ATOMIC_ACQUIRE, "agent");
            asm volatile("s_waitcnt vmcnt(0)" ::: "memory");
        }
    }
    __syncthreads();
}

constexpr int PH_PER_LAYER = 17, N_PHASES = 2 + 2 * PH_PER_LAYER;
template <int ph> __device__ __forceinline__ void run_phase(const PR& p, unsigned char* shm) {
    unsigned char* ar = p.ws + OFF_ARENA; unsigned char* W = p.ws + OFF_WMIX;
    float* xc = (float*)(p.ws + OFF_XC);
    if (ph == 0) { ph_wconv_mix(p, shm, 0); ph_mod_partial(p, shm); return; }
    if (ph == 1) { ph_mod_reduce(p); return; }
    constexpr int l = (ph - 2) / PH_PER_LAYER, q = (ph - 2) % PH_PER_LAYER;
    const float* mod = (const float*)(p.ws + OFF_MOD) + (size_t)l * 5 * 6144;
    const float* xs_lat = (l == 0) ? p.in[I_X] : p.out; const float* xs_ctx = (l == 0) ? p.in[I_CTX] : xc;
    const int MM = (l == 1) ? NLAT : NTOK;
    switch (q) {
    case 0: if (l == 0) ph_rowwise(xs_lat, xs_ctx, nullptr, nullptr, nullptr, nullptr, 0, p.in[I_NMPRE] + l * DM, 0, 1, (bf16_t*)p.out, mod, mod, NTOK, nullptr, (bf16_t*)xc); break;
    case 1: if (l == 0) {
                run_gemm<E_STORE>(shm, (const bf16_t*)p.out, 1024, (const bf16_t*)(W + W_WIN), 1024, NLAT, LDP, 1024, mk_epi<E_STORE>((bf16_t*)(ar + A_P), LDP));
                run_gemm<E_STORE>(shm, (const bf16_t*)xc, 1024, (const bf16_t*)(W + W_WIN), 1024, NCTX, LDP, 1024, mk_epi<E_STORE>((bf16_t*)(ar + A_P) + (size_t)NLAT * LDP, LDP), 128);
            } else run_gemm<E_STORE>(shm, (const bf16_t*)(ar + A_H), 1024, (const bf16_t*)(W + W_WIN), 1024, NTOK, LDP, 1024, mk_epi<E_STORE>((bf16_t*)(ar + A_P), LDP));
            break;
    case 2: ph_gla_a(p, shm, l); break;
    case 3: ph_gla_b(p); break;
    case 4: ph_gla_c(p, shm, l); break;
    case 5: ph_rw_prep(p, l); break;
    case 6: if (l >= 1) {
                run_gemm<E_LR>(shm, (const bf16_t*)(ar + A_AS), 384, (const bf16_t*)(W + W_BD), 384, NTOK, 2560, 384, mk_epi<E_LR>((bf16_t*)(ar + A_LR), 2048, (const bf16_t*)(ar + A_G), 512, p.in[I_W0] + (size_t)l * 1024, p.in[I_A0] + (size_t)l * 1024));
                run_gemm<E_STORE>(shm, (const bf16_t*)(ar + A_RKVS) + 1024, 1536, (const bf16_t*)(W + W_VD), 512, NTOK, 256, 512, mk_epi<E_STORE>((bf16_t*)(ar + A_VDB), 256), 168);
            } break;
    case 7: if (l >= 1) run_gemm<E_VRES>(shm, (const bf16_t*)(ar + A_VDB), 256, (const bf16_t*)(W + W_VU), 256, NTOK, 512, 256,
                                         mk_epi<E_VRES>((bf16_t*)(ar + A_RKVS) + 1024, 1536, (const bf16_t*)(p.ws + OFF_VF), 512, p.in[I_VB] + (size_t)(l - 1) * 512)); break;
    case 8: if (l == 0) run_gemm<E_LR>(shm, (const bf16_t*)(ar + A_AS), 384, (const bf16_t*)(W + W_BD), 384, NTOK, 2560, 384, mk_epi<E_LR>((bf16_t*)(ar + A_LR), 2048, (const bf16_t*)(ar + A_G), 512, p.in[I_W0] + (size_t)l * 1024, p.in[I_A0] + (size_t)l * 1024)); break;
    case 9: ph_rw_scan(p, shm, l); break;
    case 10: ph_rw_post(p, l, MM);
             if (l != 0) ph_rowwise(xs_lat, xs_ctx, nullptr, nullptr, nullptr, nullptr, 0, p.in[I_NMPRE] + l * DM, 0, 1, (bf16_t*)(ar + A_HR), mod, mod, MM); break;
    case 11: {
        bf16_t* G1 = (bf16_t*)(ar + A_G1); bf16_t* G2 = (bf16_t*)(ar + A_G2);
        const bf16_t* H = (l == 0) ? (const bf16_t*)p.out : (const bf16_t*)(ar + A_HR);
        run_gemm<E_SIGMOID>(shm, H, 1024, (const bf16_t*)(W + W_GRW), 1024, NLAT, 1024, 1024, mk_epi<E_SIGMOID>(G1, 1024));
        run_gemm<E_MUL>(shm, (const bf16_t*)(ar + A_YF), 512, (const bf16_t*)(W + W_RWO), 512, NLAT, 1024, 512, mk_epi<E_MUL>(G1, 1024));
        run_gemm<E_SIGMOID>(shm, H, 1024, (const bf16_t*)(W + W_GGLA), 1024, NLAT, 1024, 1024, mk_epi<E_SIGMOID>(G2, 1024));
        run_gemm<E_FMA>(shm, (const bf16_t*)(ar + A_YG), 512, (const bf16_t*)(W + W_GLO), 512, NLAT, 1024, 512, mk_epi<E_FMA>(G1, 1024, G2, 1024));
        if (l == 0) {
            const size_t ro = (size_t)NLAT; const bf16_t* Hc = (const bf16_t*)xc;
            run_gemm<E_SIGMOID>(shm, Hc, 1024, (const bf16_t*)(W + W_GRW), 1024, NCTX, 1024, 1024, mk_epi<E_SIGMOID>(G1 + ro * 1024, 1024), 64);
            run_gemm<E_MUL>(shm, (const bf16_t*)(ar + A_YF) + ro * 512, 512, (const bf16_t*)(W + W_RWO), 512, NCTX, 1024, 512, mk_epi<E_MUL>(G1 + ro * 1024, 1024), 64);
            run_gemm<E_SIGMOID>(shm, Hc, 1024, (const bf16_t*)(W + W_GGLA), 1024, NCTX, 1024, 1024, mk_epi<E_SIGMOID>(G2 + ro * 1024, 1024), 64);
            run_gemm<E_FMA>(shm, (const bf16_t*)(ar + A_YG) + ro * 512, 512, (const bf16_t*)(W + W_GLO), 512, NCTX, 1024, 512, mk_epi<E_FMA>(G1 + ro * 1024, 1024, G2 + ro * 1024, 1024), 64);
        }
    } break;
    case 12: run_gemm<E_STORE>(shm, (const bf16_t*)(ar + A_G1), 1024, (const bf16_t*)(W + W_MRG), 1024, NLAT, 1024, 1024, mk_epi<E_STORE>((bf16_t*)(ar + A_M), 1024));
             if (l == 0) {
#pragma unroll
                 for (int sl = 0; sl < 4; ++sl) run_gemm<E_F32>(shm, (const bf16_t*)(ar + A_G1) + (size_t)NLAT * 1024 + sl * 256, 1024, (const bf16_t*)(W + W_MRG) + sl * 256, 1024, NCTX, 1024, 256,
                                                                 mk_epi<E_F32>((bf16_t*)((float*)(ar + A_PART12) + (size_t)sl * NCTX * DM), 1024), 16 * sl + 64); }
             break;
    case 13: ph_rowwise(xs_lat, xs_ctx, p.out, xc, (const bf16_t*)(ar + A_M), p.in[I_NMPOST] + l * DM, 2, p.in[I_NFPRE] + l * DM, 3, 4, (bf16_t*)(ar + A_H2), mod, mod, MM, (const float*)(ar + A_PART12));
             ph_wconv_mlp(p, shm, l); break;
    case 14: run_gemm<E_RELU2>(shm, (const bf16_t*)(ar + A_H2), 1024, (const bf16_t*)(ar + A_WMLP), 1024, MM, 4096, 1024, mk_epi<E_RELU2>((bf16_t*)(ar + A_U), 4096)); break;
    case 15: run_gemm<E_STORE>(shm, (const bf16_t*)(ar + A_U), 4096, (const bf16_t*)(ar + A_WMLP) + (size_t)DFF * DM, 4096, NLAT, 1024, 4096, mk_epi<E_STORE>((bf16_t*)(ar + A_F), 1024));
             if (l == 0) {
#pragma unroll
                 for (int sl = 0; sl < 4; ++sl) run_gemm<E_F32>(shm, (const bf16_t*)(ar + A_U) + (size_t)NLAT * 4096 + sl * 1024, 4096, (const bf16_t*)(ar + A_WMLP) + (size_t)DFF * DM + sl * 1024, 4096, NCTX, 1024, 1024,
                                                                 mk_epi<E_F32>((bf16_t*)((float*)(ar + A_PART15) + (size_t)sl * NCTX * DM), 1024), 16 * sl + 64); }
             break;
    case 16:
        if (l == 0) { const float* mod1 = (const float*)(p.ws + OFF_MOD) + (size_t)5 * 6144;
            ph_rowwise(p.out, xc, p.out, xc, (const bf16_t*)(ar + A_F), p.in[I_NFPOST] + l * DM, 5, p.in[I_NMPRE] + (l + 1) * DM, 0, 1, (bf16_t*)(ar + A_H), mod, mod1, NTOK, (const float*)(ar + A_PART15));
            ph_wconv_mix(p, shm, 1); }
        else ph_rowwise(p.out, xc, p.out, xc, (const bf16_t*)(ar + A_F), p.in[I_NFPOST] + l * DM, 5, nullptr, 0, 0, nullptr, mod, mod, NLAT);
        break;
    }
}

constexpr bool phase_empty(int ph) { return ph >= 2 && ((((ph - 2) / PH_PER_LAYER) == 0 && (((ph - 2) % PH_PER_LAYER) == 6 || ((ph - 2) % PH_PER_LAYER) == 7)) || (((ph - 2) / PH_PER_LAYER) == 1 && (((ph - 2) % PH_PER_LAYER) == 0 || ((ph - 2) % PH_PER_LAYER) == 8))); }
template <int ph> __device__ __forceinline__ void phase_seq(const PR& p, unsigned char* shm, int lo, int hi, int coop, const XcdBarrier& xb) {
    if constexpr (ph < N_PHASES) {
        if constexpr (!phase_empty(ph)) {
            if (lo <= ph && ph < hi) {
                run_phase<ph>(p, shm);
                if constexpr (ph >= 2 && ph < 2 + PH_PER_LAYER && ((DBG_REP >> (ph - 2)) & 1)) { if (coop) xcd_barrier(xb); run_phase<ph>(p, shm); }
                if (coop && ph + 1 < hi) xcd_barrier(xb);
            }
        }
        phase_seq<ph + 1>(p, shm, lo, hi, coop, xb);
    }
}
__global__ void __launch_bounds__(NTHREADS, 2) k_mega(PR p, int ph_lo, int ph_hi, int coop) {
    extern __shared__ __attribute__((aligned(16))) unsigned char shm[];
    XcdBarrier xb; xb.bar = nullptr; xb.x = 0; xb.st = (volatile LAS unsigned*)(shm + LDS_BYTES - 16);
    if (coop) {
        if (coop > 1) cg::this_grid().sync();
        if (threadIdx.x == 0) { xb.st[0] = 0u; xb.st[1] = 0u; }
        __syncthreads();
        xb = xcd_barrier_post((unsigned*)(p.ws + OFF_BAR), (volatile LAS unsigned*)(shm + LDS_BYTES - 16));
    }
    phase_seq<0>(p, shm, ph_lo, ph_hi, coop, xb);
}

#if DBG_HI
__global__ void k_dump(PR p, size_t off, int nelem) {
    const bf16_t* src = (const bf16_t*)(p.ws + off);
    for (int i = blockIdx.x * blockDim.x + threadIdx.x; i < NLAT * DM; i += gridDim.x * blockDim.x) p.out[i] = (i < nelem) ? bf2f(src[i]) : 0.f;
}
#endif
extern "C" void kernel_launch(void* const* d_in, const int* in_sizes, int n_in, void* d_out, int out_size, void* d_ws, size_t ws_size, hipStream_t stream) {
    static int grid = 0;
    if (grid == 0) {
        if (n_in != N_IN || ws_size < WS_NEED) { fprintf(stderr, "kernel_launch: unexpected inputs (%d) or workspace (%zu < %zu)\n", n_in, ws_size, (size_t)WS_NEED); grid = -1; return; }
        int dev = 0, cus = 0, per_cu = 0;
        hipGetDevice(&dev); hipDeviceGetAttribute(&cus, hipDeviceAttributeMultiprocessorCount, dev);
        hipFuncSetAttribute((const void*)k_mega, hipFuncAttributeMaxDynamicSharedMemorySize, LDS_BYTES);
        hipOccupancyMaxActiveBlocksPerMultiprocessor(&per_cu, (const void*)k_mega, NTHREADS, LDS_BYTES);
        (void)hipGetLastError();
        if (per_cu < 1) per_cu = 1;
        grid = cus * 1;
        if (grid > 256) grid = 256;
    }
    if (grid < 0) return;
    PR p{};
    for (int i = 0; i < N_IN; ++i) p.in[i] = (const float*)d_in[i];
    p.out = (float*)d_out; p.ws = (unsigned char*)d_ws;
#if MEGA
    if (hipMemsetAsync((char*)d_ws + OFF_BAR, 0, XCD_BAR_WORDS * 4, stream) != hipSuccess) { fprintf(stderr, "kernel_launch: memset of the barrier words failed\n"); return; }
    int lo = 0, hi = N_PHASES, coop = 1;
    void* args[] = {&p, &lo, &hi, &coop};
    hipError_t e = hipLaunchCooperativeKernel((const void*)k_mega, dim3(grid), dim3(NTHREADS), args, LDS_BYTES, stream);
    if (e != hipSuccess) fprintf(stderr, "cooperative launch failed: %s (grid %d)\n", hipGetErrorString(e), grid);
#else
    for (int ph = 0; ph < (DBG_HI ? DBG_HI : N_PHASES); ++ph) {
        const int l = (ph - 2) / PH_PER_LAYER, q = (ph - 2) % PH_PER_LAYER;
        if (ph >= 2 && ((l == 0 && (q == 6 || q == 7)) || (l == 1 && q == 0))) continue;
        hipLaunchKernelGGL(k_mega, dim3(grid), dim3(NTHREADS), LDS_BYTES, stream, p, ph, ph + 1, 0);
    }
#if DBG_HI
#ifdef DBG_OFF
    hipLaunchKernelGGL(k_dump, dim3(1024), dim3(256), 0, stream, p, (size_t)(DBG_OFF), (int)(DBG_N));
#endif
#endif
#endif
}
```

```cpp
#include <hip/hip_runtime.h>
#include <hip/hip_cooperative_groups.h>
#include <cstdio>
namespace cg = cooperative_groups;

#ifndef MEGA
#define MEGA 1
#endif
#ifndef DBG_REP
#define DBG_REP 0
#endif
#ifndef DBG_HI
#define DBG_HI 0
#define DBG_OFF (OFF_ARENA + A_KV)
#define DBG_N (NLAT * DM)
#endif

#define LAS __attribute__((address_space(3)))
typedef unsigned short bf16_t;
typedef short bf16x8 __attribute__((ext_vector_type(8)));
typedef float f32x4 __attribute__((ext_vector_type(4)));
typedef unsigned u32x4 __attribute__((ext_vector_type(4)));
typedef unsigned u32x2 __attribute__((ext_vector_type(2)));

constexpr int DM = 1024, NB = 4, SEQ = 4096, CTX = 256, NLAT = NB * SEQ, NCTX = NB * CTX, NTOK = NLAT + NCTX;
constexpr int INC = 5536, DFF = 4096;
constexpr int LDP = 3584;
constexpr int P_R = 0, P_K = 512, P_V = 1024, P_LRIN = 1536, P_GQ = 1920, P_GK = 2176, P_GV = 2432, P_ALF = 2944, P_ALB = 2960, P_GG = 2976;
constexpr int NTHREADS = 512;
constexpr int LDS_BYTES = 147456;

enum { I_X = 0, I_C, I_CTX, I_CCTX, I_WIN, I_MU, I_W0, I_WUP, I_A0, I_AUP, I_GUP, I_KK, I_KA, I_RK, I_GNW, I_GNB, I_VDN, I_VUP, I_VB, I_RWO, I_CONV, I_ALUP, I_ALB,
       I_GNORM, I_GLO, I_MRG, I_W1, I_W2, I_ADAW, I_ADAB, I_NMPRE, I_NMPOST, I_NFPRE, I_NFPOST, N_IN };

struct PR { const float* in[N_IN]; float* out; unsigned char* ws; };

constexpr size_t UU = (size_t)NTOK * 1024 * 2;
constexpr size_t OFF_XC = 0;
constexpr size_t OFF_VF = OFF_XC + (size_t)NCTX * DM * 4;
constexpr size_t OFF_MOD = OFF_VF + (size_t)NTOK * 512 * 2;
constexpr size_t OFF_MODP = OFF_MOD + 2 * 5 * 6144 * 4;
constexpr size_t OFF_KINV = OFF_MODP + 8 * 2 * 5 * 6144 * 4;
constexpr size_t OFF_BON = OFF_KINV + (size_t)NTOK * 8 * 4;
constexpr size_t OFF_GDEC = OFF_BON + 2 * (size_t)NTOK * 8 * 4;
constexpr size_t OFF_BAR = OFF_GDEC + 2176 * 64 * 4;
constexpr size_t OFF_WMIX = OFF_BAR + 16384;
constexpr size_t W_WIN = 0, W_GRW = W_WIN + (size_t)LDP * 1024 * 2, W_GGLA = W_GRW + 1024 * 1024 * 2, W_RWO = W_GGLA + 1024 * 1024 * 2, W_GLO = W_RWO + 1024 * 512 * 2,
                 W_MRG = W_GLO + 1024 * 512 * 2, W_BD = W_MRG + 1024 * 1024 * 2, W_VD = W_BD + 2560 * 384 * 2, W_VU = W_VD + 256 * 512 * 2, W_MIX_END = W_VU + 512 * 256 * 2;
constexpr size_t OFF_ARENA = OFF_WMIX + W_MIX_END;
constexpr size_t A_P = 0, A_H = UU * 7 / 2, A_YG = UU * 7 / 2, A_KV = UU * 4, A_RKVS = UU * 4, A_AS = UU * 11 / 2, A_VDB = UU * 47 / 8, A_LR = 0, A_G = UU * 2, A_YF = UU * 5 / 2,
                 A_YB = UU * 3, A_HR = 0, A_G1 = UU, A_G2 = UU * 4, A_M = UU * 5, A_H2 = 0, A_WMLP = UU, A_U = UU * 3 / 2, A_F = 0, A_PART12 = UU * 2, A_PART15 = UU * 11 / 2;
constexpr size_t WS_NEED = OFF_ARENA + UU * 49 / 8;

__device__ __forceinline__ int otid() { int t = threadIdx.x; asm volatile("" : "+v"(t)); return t; }
__device__ __forceinline__ float bf2f(bf16_t v) { return __uint_as_float(((unsigned)v) << 16); }
typedef __bf16 hbf2_t __attribute__((ext_vector_type(2)));
typedef float hf2_t __attribute__((ext_vector_type(2)));
__device__ __forceinline__ unsigned cvt_pk_bf16(float lo, float hi) { const hf2_t v = {lo, hi}; return __builtin_bit_cast(unsigned, __builtin_convertvector(v, hbf2_t)); }
__device__ __forceinline__ bf16_t f2bf(float f) { return (bf16_t)(cvt_pk_bf16(f, 0.f) & 0xffffu); }
__device__ __forceinline__ float lo_bf(unsigned u) { return __uint_as_float(u << 16); }
__device__ __forceinline__ float hi_bf(unsigned u) { return __uint_as_float(u & 0xffff0000u); }
__device__ __forceinline__ float sigm(float x) { return __builtin_amdgcn_rcpf(1.f + __expf(-x)); }
__device__ __forceinline__ float siluf(float x) { return x * sigm(x); }
__device__ __forceinline__ float wave_sum(float v) {
#pragma unroll
    for (int o = 32; o > 0; o >>= 1) v += __shfl_xor(v, o);
    return v;
}
template <int CTRL> __device__ __forceinline__ float dppf(float x) { return __int_as_float(__builtin_amdgcn_update_dpp(0, __float_as_int(x), CTRL, 0xf, 0xf, true)); }
__device__ __forceinline__ float row16_sum(float x) {
    x += dppf<0x128>(x); x += dppf<0x124>(x); x += dppf<0x122>(x); x += dppf<0x121>(x); return x;
}
__device__ __forceinline__ int tok_of(int s, int p, int colorder) {
    if (s >= 4) return NLAT + (s - 4) * CTX + p;
    const int t = colorder ? (((p & 63) << 6) | (p >> 6)) : p;
    return s * SEQ + t;
}

namespace pg8 {
constexpr int BM = 256, BK = 64, HALF = 128, HTB = HALF * BK * 2, NXCD = 8, WGM = 8;
__host__ __device__ __forceinline__ int lds_byte(int r, int c) { const int st = (r >> 4) * 2 + (c >> 5), rr = r & 15, cc = c & 31, ob = rr * 64 + cc * 2; return st * 1024 + (ob ^ (((ob >> 9) & 1) << 5)); }
__host__ __device__ __forceinline__ void stage_rc(int b, int& R, int& C) { const int st = b / 1024, sb = b % 1024, swz = sb ^ (((sb >> 9) & 1) << 5); R = (st >> 1) * 16 + swz / 64; C = (st & 1) * 32 + (swz % 64) / 2; }
__host__ __device__ __forceinline__ int perm32(int rho) { const int n = rho >> 4, i = rho & 15; return 8 * (i >> 2) + 4 * n + (i & 3); }
struct Unit { int pm, pn; };
struct Gemm { const bf16_t* A; const bf16_t* Bt; int M, N, K, lda, ldb; };
struct StaticOrder {
    int nM, nN, nwg, G, c;
    __device__ void init(int M, int N, int G_, int c_) { nM = M / BM; nN = N / BM; nwg = nM * nN; G = G_; c = c_; }
    __device__ bool next(int i, Unit& u) const {
        const long L = (long)i * G + c; if (L >= nwg) return false;
        int wgid = (int)L; { const int q = nwg / NXCD, r = nwg % NXCD, xcd = wgid % NXCD, off = wgid / NXCD; wgid = (xcd < r ? xcd * (q + 1) : r * (q + 1) + (xcd - r) * q) + off; }
        const int nig = WGM * nN, gid = wgid / nig, fm = gid * WGM, gsz = (nM - fm) < WGM ? (nM - fm) : WGM;
        u.pm = fm + ((wgid % nig) % gsz); u.pn = (wgid % nig) / gsz; return true;
    }
};

template <class Epi>
__device__ __forceinline__ void gemm_phase(LAS unsigned char* lds, const Gemm g, const StaticOrder& S, const Epi& E) {
    int tid = threadIdx.x; asm volatile("" : "+v"(tid));
    const int wid = __builtin_amdgcn_readfirstlane(tid >> 6), lane = tid & 63, wr = wid >> 2, wc = wid & 3, fr = lane & 15, fq = lane >> 4;
    int K = g.K; asm volatile("" : "+s"(K));
    const int nt = K / BK;
    unsigned voffA[2], voffB[2];
#pragma unroll
    for (int i = 0; i < 2; ++i) { int R, C; stage_rc(tid * 16 + i * 8192, R, C); const int Rb = (R & ~31) + perm32(R & 31);
        voffA[i] = (unsigned)(R * g.lda + C) * 2u; voffB[i] = (unsigned)(Rb * g.ldb + C) * 2u; }
    const size_t kstep = (size_t)(BK * 2);
    const size_t hstepA = (size_t)HALF * g.lda * 2, hstepB = (size_t)HALF * g.ldb * 2;
    const size_t tstepA = 2 * hstepA, tstepB = 2 * hstepB;
    const unsigned ldsw = (unsigned)wid * 1024u;
    const int aoff = lds_byte(wr * 64 + fr, fq * 8), boff = lds_byte(wc * 32 + fr, fq * 8);
#define PG8_SA(b, h) (((b) * 2 + (h)) * HTB)
#define PG8_SB(b, h) ((4 + (b) * 2 + (h)) * HTB)
#define PG8_STAGE(bufoff, gbase, voff) do { _Pragma("unroll") for (int _i = 0; _i < 2; ++_i) \
        __builtin_amdgcn_global_load_lds((const unsigned*)((const char*)(gbase) + (voff)[_i]), (LAS unsigned*)(lds + (bufoff) + ldsw + _i * 8192), 16, 0, 0); } while (0)
#define PG8_LDA(dst, b, h) do { _Pragma("unroll") for (int m = 0; m < 4; ++m) _Pragma("unroll") for (int k = 0; k < 2; ++k) dst[m][k] = *(const LAS bf16x8*)(lds + PG8_SA(b, h) + aoff + m * 2048 + k * 1024); } while (0)
#define PG8_LDB(dst, b, h) do { _Pragma("unroll") for (int n = 0; n < 2; ++n) _Pragma("unroll") for (int k = 0; k < 2; ++k) dst[n][k] = *(const LAS bf16x8*)(lds + PG8_SB(b, h) + boff + n * 2048 + k * 1024); } while (0)
#define PG8_MMA(ai, bj, At, Bt) do { __builtin_amdgcn_s_setprio(1); _Pragma("unroll") for (int m = 0; m < 4; ++m) _Pragma("unroll") for (int n = 0; n < 2; ++n) _Pragma("unroll") for (int k = 0; k < 2; ++k) \
        acc[ai][bj][m][n] = __builtin_amdgcn_mfma_f32_16x16x32_bf16(Bt[n][k], At[m][k], acc[ai][bj][m][n], 0, 0, 0); __builtin_amdgcn_s_setprio(0); } while (0)
#define PG8_WAIT_V(n) asm volatile("s_waitcnt vmcnt(" #n ")" ::: "memory")
#define PG8_WAIT_L(n) asm volatile("s_waitcnt lgkmcnt(" #n ")" ::: "memory")
#define PG8_BAR __builtin_amdgcn_s_barrier()
#define PG8_SCHED __builtin_amdgcn_sched_barrier(0)
    Unit cur, nxt; int ui = 0;
    if (!S.next(0, cur)) return;
    f32x4 acc[2][2][4][2];
#pragma unroll
    for (int a = 0; a < 2; ++a)
#pragma unroll
        for (int b = 0; b < 2; ++b)
#pragma unroll
            for (int m = 0; m < 4; ++m)
#pragma unroll
                for (int n = 0; n < 2; ++n) acc[a][b][m][n] = (f32x4){0.f, 0.f, 0.f, 0.f};
    bf16x8 At[4][2], B0[2][2], B1[2][2];
    const char* cA = (const char*)g.A + (size_t)cur.pm * tstepA; const char* cB = (const char*)g.Bt + (size_t)cur.pn * tstepB;
    PG8_STAGE(PG8_SB(0, 0), cB, voffB); PG8_STAGE(PG8_SA(0, 0), cA, voffA); PG8_STAGE(PG8_SB(0, 1), cB + hstepB, voffB); PG8_STAGE(PG8_SA(0, 1), cA + hstepA, voffA);
    if (wr == 1) PG8_BAR;
    PG8_WAIT_V(4); PG8_BAR;
    PG8_STAGE(PG8_SB(1, 0), cB + kstep, voffB); PG8_STAGE(PG8_SA(1, 0), cA + kstep, voffA); PG8_STAGE(PG8_SB(1, 1), cB + hstepB + kstep, voffB);
    PG8_WAIT_V(6); PG8_BAR;
    for (;;) {
        const bool has_next = S.next(ui + 1, nxt);
        const char* nA = has_next ? (const char*)g.A + (size_t)nxt.pm * tstepA : cA; const char* nB = has_next ? (const char*)g.Bt + (size_t)nxt.pn * tstepB : cB;
#pragma nounroll
        for (int t = 0; t < nt; t += 2) {
            const bool last = (t == nt - 2);
            const char* a1 = cA + (size_t)(t + 1) * kstep;
            const char* a2 = last ? nA : cA + (size_t)(t + 2) * kstep; const char* b2 = last ? nB : cB + (size_t)(t + 2) * kstep;
            const char* a3 = a2 + kstep; const char* b3 = b2 + kstep;
            PG8_LDB(B0, 0, 0); PG8_SCHED; PG8_LDA(At, 0, 0); PG8_STAGE(PG8_SA(1, 1), a1 + hstepA, voffA);
            PG8_WAIT_L(8); PG8_BAR; PG8_WAIT_L(0); PG8_MMA(0, 0, At, B0); PG8_BAR; PG8_SCHED;
            PG8_LDB(B1, 0, 1); PG8_STAGE(PG8_SB(0, 0), b2, voffB);
            PG8_BAR; PG8_WAIT_L(0); PG8_MMA(0, 1, At, B1); PG8_BAR;
            PG8_LDA(At, 0, 1); PG8_STAGE(PG8_SA(0, 0), a2, voffA);
            PG8_BAR; PG8_WAIT_L(0); PG8_MMA(1, 0, At, B0); PG8_BAR; PG8_SCHED;
            PG8_STAGE(PG8_SB(0, 1), b2 + hstepB, voffB);
            PG8_WAIT_V(6); PG8_BAR; PG8_MMA(1, 1, At, B1); PG8_BAR;
            PG8_LDB(B0, 1, 0); PG8_SCHED; PG8_LDA(At, 1, 0); PG8_STAGE(PG8_SA(0, 1), a2 + hstepA, voffA);
            PG8_WAIT_L(8); PG8_BAR; PG8_WAIT_L(0); PG8_MMA(0, 0, At, B0); PG8_BAR; PG8_SCHED;
            PG8_LDB(B1, 1, 1); PG8_STAGE(PG8_SB(1, 0), b3, voffB);
            PG8_BAR; PG8_WAIT_L(0); PG8_MMA(0, 1, At, B1); PG8_BAR;
            PG8_LDA(At, 1, 1); PG8_STAGE(PG8_SA(1, 0), a3, voffA);
            PG8_BAR; PG8_WAIT_L(0); PG8_MMA(1, 0, At, B0); PG8_BAR; PG8_SCHED;
            PG8_STAGE(PG8_SB(1, 1), b3 + hstepB, voffB);
            PG8_WAIT_V(6); PG8_BAR; PG8_MMA(1, 1, At, B1); PG8_BAR;
        }
        E(acc, cur, wr, wc, fr, fq);
        if (!has_next) break;
#pragma unroll
        for (int a = 0; a < 2; ++a)
#pragma unroll
            for (int b = 0; b < 2; ++b)
#pragma unroll
                for (int m = 0; m < 4; ++m)
#pragma unroll
                    for (int n = 0; n < 2; ++n) acc[a][b][m][n] = (f32x4){0.f, 0.f, 0.f, 0.f};
        cur = nxt; cA = nA; cB = nB; ++ui;
    }
    PG8_WAIT_V(0);
    if (wr == 0) PG8_BAR;
    PG8_BAR;
#undef PG8_SA
#undef PG8_SB
#undef PG8_STAGE
#undef PG8_LDA
#undef PG8_LDB
#undef PG8_MMA
#undef PG8_WAIT_V
#undef PG8_WAIT_L
#undef PG8_BAR
#undef PG8_SCHED
}
}

enum { E_STORE = 0, E_SIGMOID, E_MUL, E_FMA, E_RELU2, E_VRES, E_LR, E_F32 };
template <int MODE> struct Epi {
    bf16_t* d0; int ld0;
    const bf16_t* aux; int ldaux; const float* bias; const float* bias2;
    __device__ __forceinline__ void operator()(const f32x4 (&acc)[2][2][4][2], const pg8::Unit& u, int wr, int wc, int fr, int fq) const {
        const int row0 = u.pm * 256 + wr * 64 + fr; const int colt = u.pn * 256; bf16_t* base = d0; const int ld = ld0;
        const int col0 = colt + wc * 32 + 8 * fq;
#pragma unroll
        for (int ai = 0; ai < 2; ++ai)
#pragma unroll
            for (int m = 0; m < 4; ++m) {
                const int row = row0 + ai * 128 + m * 16;
#pragma unroll
                for (int bj = 0; bj < 2; ++bj) {
                    const int c = col0 + bj * 128;
                    if (MODE == E_F32) {
                        float* fp = (float*)d0 + (size_t)row * ld + c; *(f32x4*)fp = acc[ai][bj][m][0]; *(f32x4*)(fp + 4) = acc[ai][bj][m][1];
                        continue;
                    }
                    if (MODE == E_VRES) {
#pragma unroll
                        for (int hh = 0; hh < 2; ++hh) {
                            bf16_t* p4 = base + (size_t)row * ld + c + 4 * hh;
                            const u32x2 o = *(const u32x2*)p4; const u32x2 g = *(const u32x2*)(aux + (size_t)row * ldaux + c + 4 * hh); const f32x4 bb = *(const f32x4*)(bias + c + 4 * hh);
                            const f32x4 a4 = acc[ai][bj][m][hh];
                            float r4[4];
#pragma unroll
                            for (int j = 0; j < 2; ++j) {
                                const float v0 = __uint_as_float(o[j] << 16), v1 = __uint_as_float(o[j] & 0xffff0000u), f0 = __uint_as_float(g[j] << 16), f1 = __uint_as_float(g[j] & 0xffff0000u);
                                r4[2 * j] = v0 + (f0 - v0) * sigm(bb[2 * j] + a4[2 * j]); r4[2 * j + 1] = v1 + (f1 - v1) * sigm(bb[2 * j + 1] + a4[2 * j + 1]); }
                            u32x2 w2; w2[0] = cvt_pk_bf16(r4[0], r4[1]); w2[1] = cvt_pk_bf16(r4[2], r4[3]);
                            *(u32x2*)p4 = w2;
                            __builtin_amdgcn_sched_barrier(0);
                        }
                        continue;
                    }
                    float v[8];
#pragma unroll
                    for (int j = 0; j < 4; ++j) { v[j] = acc[ai][bj][m][0][j]; v[4 + j] = acc[ai][bj][m][1][j]; }
                    bf16_t* ptr = base + (size_t)row * ld + c;
                    if (MODE == E_LR && colt >= 2048) {
                        ptr = (bf16_t*)aux + (size_t)row * ldaux + (c - 2048);
                    } else if (MODE == E_LR) {
                        const float* bp = (colt < 1024) ? bias + c : bias2 + (c - 1024);
                        const f32x4 b0 = *(const f32x4*)bp, b1 = *(const f32x4*)(bp + 4);
#pragma unroll
                        for (int j = 0; j < 4; ++j) { v[j] += b0[j]; v[4 + j] += b1[j]; }
                        if (colt < 1024) {
#pragma unroll
                            for (int j = 0; j < 8; ++j) { const float sp = fmaxf(-v[j], 0.f) + __logf(1.f + __expf(-fabsf(v[j]))); v[j] = __expf(-sp - 0.5f); }
                        } else {
#pragma unroll
                            for (int j = 0; j < 8; ++j) v[j] = sigm(v[j]);
                        }
                    } else if (MODE == E_SIGMOID) {
#pragma unroll
                        for (int j = 0; j < 8; ++j) v[j] = sigm(v[j]);
                    } else if (MODE == E_RELU2) {
#pragma unroll
                        for (int j = 0; j < 8; ++j) { const float t = fmaxf(v[j], 0.f); v[j] = t * t; }
                    } else if (MODE == E_MUL) {
                        const u32x4 o = *(const u32x4*)ptr;
#pragma unroll
                        for (int j = 0; j < 4; ++j) { v[2 * j] *= __uint_as_float(o[j] << 16); v[2 * j + 1] *= __uint_as_float(o[j] & 0xffff0000u); }
                    } else if (MODE == E_FMA) {
                        const u32x4 o = *(const u32x4*)ptr; const u32x4 g = *(const u32x4*)(aux + (size_t)row * ldaux + c);
#pragma unroll
                        for (int j = 0; j < 4; ++j) { v[2 * j] = __uint_as_float(o[j] << 16) + __uint_as_float(g[j] << 16) * v[2 * j];
                            v[2 * j + 1] = __uint_as_float(o[j] & 0xffff0000u) + __uint_as_float(g[j] & 0xffff0000u) * v[2 * j + 1]; }
                    }
                    u32x4 w; w.x = cvt_pk_bf16(v[0], v[1]); w.y = cvt_pk_bf16(v[2], v[3]); w.z = cvt_pk_bf16(v[4], v[5]); w.w = cvt_pk_bf16(v[6], v[7]);
                    *(u32x4*)ptr = w;
                    if (MODE >= E_MUL) __builtin_amdgcn_sched_barrier(0);
                }
            }
    }
};
template <int MODE>
__device__ __forceinline__ void run_gemm(unsigned char* shm, const bf16_t* A, int lda, const bf16_t* Bt, int ldb, int M, int N, int K, const Epi<MODE>& E, int coff = 0) {
    pg8::Gemm g; g.A = A; g.Bt = Bt; g.M = M; g.N = N; g.K = K; g.lda = lda; g.ldb = ldb;
    pg8::StaticOrder S; S.init(M, N, (int)gridDim.x, (int)((blockIdx.x + gridDim.x - coff) % gridDim.x));
    pg8::gemm_phase<Epi<MODE>>((LAS unsigned char*)shm, g, S, E);
}
template <int MODE> __device__ __forceinline__ Epi<MODE> mk_epi(bf16_t* d0, int ld0, const bf16_t* aux = nullptr, int ldaux = 0, const float* bias = nullptr, const float* bias2 = nullptr) {
    Epi<MODE> e; e.bias2 = bias2; e.d0 = d0; e.ld0 = ld0; e.aux = aux; e.ldaux = ldaux; e.bias = bias; return e;
}

__device__ __forceinline__ int tconv_tiles(int K, int nrows) { return (K / 64) * (nrows / 64); }
__device__ __forceinline__ void tconv_tile(unsigned char* shm, const float* src, int sld, int c0, int K, int ncols, int nrows, bf16_t* dst, int ldd, int tile) {
    float* t = (float*)shm;
    const int nkt = K / 64, ti = tile % nkt, tj = tile / nkt;
    const int tid = otid();
    __syncthreads();
#pragma unroll
    for (int r = 0; r < 2; ++r) { const int e = tid + r * NTHREADS, i = e >> 4, c4 = e & 15, j = tj * 64 + c4 * 4;
        f32x4 v = {0.f, 0.f, 0.f, 0.f};
        if (j < ncols) v = *(const f32x4*)(src + (size_t)(ti * 64 + i) * sld + c0 + j);
        t[i * 65 + c4 * 4] = v[0]; t[i * 65 + c4 * 4 + 1] = v[1]; t[i * 65 + c4 * 4 + 2] = v[2]; t[i * 65 + c4 * 4 + 3] = v[3]; }
    __syncthreads();
    { const int jl = tid >> 3, ko = tid & 7;
        float f[8];
#pragma unroll
        for (int m = 0; m < 8; ++m) f[m] = t[(ko * 8 + m) * 65 + jl];
        u32x4 w; w.x = cvt_pk_bf16(f[0], f[1]); w.y = cvt_pk_bf16(f[2], f[3]); w.z = cvt_pk_bf16(f[4], f[5]); w.w = cvt_pk_bf16(f[6], f[7]);
        *(u32x4*)(dst + (size_t)(tj * 64 + jl) * ldd + ti * 64 + ko * 8) = w; }
}
__device__ __forceinline__ void ph_wconv_mix(const PR& p, unsigned char* shm, int l) {
    unsigned char* W = p.ws + OFF_WMIX;
    const float* win = p.in[I_WIN] + (size_t)l * DM * INC;
    const int n0 = tconv_tiles(1024, LDP), n1 = n0 + tconv_tiles(1024, 1024), n2 = n1 + tconv_tiles(1024, 1024), n3 = n2 + tconv_tiles(512, 1024), n4 = n3 + tconv_tiles(512, 1024), n5 = n4 + tconv_tiles(1024, 1024);
    for (int it = blockIdx.x; it < n5; it += gridDim.x) {
        if (it < n0) tconv_tile(shm, win, INC, 0, 1024, 3488, LDP, (bf16_t*)(W + W_WIN), 1024, it);
        else if (it < n1) tconv_tile(shm, win, INC, 3488, 1024, 1024, 1024, (bf16_t*)(W + W_GRW), 1024, it - n0);
        else if (it < n2) tconv_tile(shm, win, INC, 4512, 1024, 1024, 1024, (bf16_t*)(W + W_GGLA), 1024, it - n1);
        else if (it < n3) tconv_tile(shm, p.in[I_RWO] + (size_t)l * 512 * 1024, 1024, 0, 512, 1024, 1024, (bf16_t*)(W + W_RWO), 512, it - n2);
        else if (it < n4) tconv_tile(shm, p.in[I_GLO] + (size_t)l * 512 * 1024, 1024, 0, 512, 1024, 1024, (bf16_t*)(W + W_GLO), 512, it - n3);
        else tconv_tile(shm, p.in[I_MRG] + (size_t)l * 1024 * 1024, 1024, 0, 1024, 1024, 1024, (bf16_t*)(W + W_MRG), 1024, it - n4);
    }
    const size_t gt = (size_t)blockIdx.x * NTHREADS + otid(), gs = (size_t)gridDim.x * NTHREADS;
    bf16_t* bd = (bf16_t*)(W + W_BD);
    for (size_t e = gt; e < (size_t)2560 * 384; e += gs) {
        const int row = (int)(e / 384), k = (int)(e % 384); float v = 0.f;
        if (row < 2048) { const int blk = row >> 9, j = row & 511; if ((k >> 6) == blk) { const int kk = k & 63;
                const float* src = (blk < 2) ? p.in[I_WUP] + ((size_t)(l * 2 + blk) * 64) * 512 : p.in[I_AUP] + ((size_t)(l * 2 + (blk - 2)) * 64) * 512; v = src[(size_t)kk * 512 + j]; } }
        else { const int j = row - 2048; if (k >= 256) v = p.in[I_GUP][((size_t)l * 128 + (k - 256)) * 512 + j]; }
        bd[e] = f2bf(v);
    }
    if (l >= 1) {
        bf16_t* vd = (bf16_t*)(W + W_VD); bf16_t* vu = (bf16_t*)(W + W_VU);
        const float* dn = p.in[I_VDN] + (size_t)(l - 1) * 512 * 32; const float* up = p.in[I_VUP] + (size_t)(l - 1) * 32 * 512;
        for (size_t e = gt; e < (size_t)256 * 512; e += gs) { const int row = (int)(e / 512), k = (int)(e % 512); vd[e] = f2bf(row < 32 ? dn[(size_t)k * 32 + row] : 0.f); }
        for (size_t e = gt; e < (size_t)512 * 256; e += gs) { const int row = (int)(e / 256), k = (int)(e % 256); vu[e] = f2bf(k < 32 ? up[(size_t)k * 512 + row] : 0.f); }
    }
}
__device__ __forceinline__ void ph_wconv_mlp(const PR& p, unsigned char* shm, int l) {
    bf16_t* w1 = (bf16_t*)(p.ws + OFF_ARENA + A_WMLP); bf16_t* w2 = w1 + (size_t)DFF * DM;
    const int n0 = tconv_tiles(1024, 4096), n1 = n0 + tconv_tiles(4096, 1024);
    for (int it = blockIdx.x; it < n1; it += gridDim.x) {
        if (it < n0) tconv_tile(shm, p.in[I_W1] + (size_t)l * DM * DFF, DFF, 0, 1024, 4096, 4096, w1, 1024, it);
        else tconv_tile(shm, p.in[I_W2] + (size_t)l * DFF * DM, DM, 0, 4096, 1024, 1024, w2, 4096, it - n0);
    }
}

__device__ __forceinline__ void ph_mod_partial(const PR& p, unsigned char* shm) {
    float* sc = (float*)shm;
    float* modp = (float*)(p.ws + OFF_MODP);
    for (int it = blockIdx.x; it < 2 * 12 * 8; it += gridDim.x) {
        const int ks = it & 7, cb = (it >> 3) % 12, l = it / 96;
        __syncthreads();
        for (int e = otid(); e < 5 * 128; e += NTHREADS) { const int j = e >> 7, k = ks * 128 + (e & 127); const float cv = (j < 4) ? p.in[I_C][j * 1024 + k] : p.in[I_CCTX][k]; sc[e] = siluf(cv); }
        __syncthreads();
        const int col = cb * 512 + otid();
        const float* w = p.in[I_ADAW] + ((size_t)l * 1024 + ks * 128) * 6144 + col;
        float a0 = 0, a1 = 0, a2 = 0, a3 = 0, a4 = 0;
#pragma unroll 8
        for (int k = 0; k < 128; ++k) { const float wv = w[(size_t)k * 6144]; a0 += sc[k] * wv; a1 += sc[128 + k] * wv; a2 += sc[256 + k] * wv; a3 += sc[384 + k] * wv; a4 += sc[512 + k] * wv; }
        float* o = modp + ((size_t)(ks * 2 + l) * 5) * 6144 + col;
        o[0] = a0; o[6144] = a1; o[2 * 6144] = a2; o[3 * 6144] = a3; o[4 * 6144] = a4;
    }
}
__device__ __forceinline__ void ph_mod_reduce(const PR& p) {
    const float* modp = (const float*)(p.ws + OFF_MODP); float* mod = (float*)(p.ws + OFF_MOD);
    for (int e = blockIdx.x * NTHREADS + otid(); e < 2 * 5 * 6144; e += gridDim.x * NTHREADS) {
        const int l = e / (5 * 6144), col = e % 6144; float a = p.in[I_ADAB][l * 6144 + col];
#pragma unroll
        for (int ks = 0; ks < 8; ++ks) a += modp[(size_t)ks * 2 * 5 * 6144 + e];
        mod[e] = a;
    }
}

__device__ __forceinline__ void ph_rowwise(const float* xs_lat, const float* xs_ctx, float* xd_lat, float* xd_ctx, const bf16_t* Y, const float* norm_post, int gate_idx,
                           const float* norm_pre, int shift_idx, int scale_idx, bf16_t* Hout, const float* mod, const float* mod_pre, int nrows, const float* Ypart = nullptr, bf16_t* Hctx = nullptr) {
    const int wave = otid() >> 6, lane = otid() & 63;
    auto load_row = [&](int n, float (&x)[16], float (&y)[16]) {
        const float* xs = (n < NLAT) ? xs_lat + (size_t)n * DM : xs_ctx + (size_t)(n - NLAT) * DM;
#pragma unroll
        for (int i = 0; i < 4; ++i) { const f32x4 t = *(const f32x4*)(xs + i * 256 + lane * 4); x[4 * i] = t[0]; x[4 * i + 1] = t[1]; x[4 * i + 2] = t[2]; x[4 * i + 3] = t[3]; }
        if (Y) {
            if (Ypart && n >= NLAT) {
#pragma unroll
                for (int i = 0; i < 4; ++i) { f32x4 a = {0.f, 0.f, 0.f, 0.f};
#pragma unroll
                    for (int sl = 0; sl < 4; ++sl) a += *(const f32x4*)(Ypart + ((size_t)sl * NCTX + (n - NLAT)) * DM + i * 256 + lane * 4);
                    y[4 * i] = a[0]; y[4 * i + 1] = a[1]; y[4 * i + 2] = a[2]; y[4 * i + 3] = a[3]; }
            } else {
#pragma unroll
                for (int i = 0; i < 4; ++i) { const u32x2 t = *(const u32x2*)(Y + (size_t)n * DM + i * 256 + lane * 4);
                    y[4 * i] = lo_bf(t[0]); y[4 * i + 1] = hi_bf(t[0]); y[4 * i + 2] = lo_bf(t[1]); y[4 * i + 3] = hi_bf(t[1]); }
            }
        }
    };
    auto finish_row = [&](int n, float (&x)[16], float (&y)[16]) {
        const float* md = mod + (size_t)((n < NLAT) ? (n >> 12) : 4) * 6144;
        const float* mdp = mod_pre + (size_t)((n < NLAT) ? (n >> 12) : 4) * 6144;
        if (Y) {
            float ss = 0.f;
#pragma unroll
            for (int i = 0; i < 16; ++i) ss += y[i] * y[i];
            ss = wave_sum(ss);
            const float rstd = rsqrtf(ss * (1.f / 1024.f) + 1e-6f);
            float* xd = (n < NLAT) ? xd_lat + (size_t)n * DM : xd_ctx + (size_t)(n - NLAT) * DM;
#pragma unroll
            for (int i = 0; i < 4; ++i) { const int c = i * 256 + lane * 4; const f32x4 np = *(const f32x4*)(norm_post + c); const f32x4 gt = *(const f32x4*)(md + gate_idx * 1024 + c);
                f32x4 o;
#pragma unroll
                for (int j = 0; j < 4; ++j) { x[4 * i + j] += gt[j] * (y[4 * i + j] * rstd * np[j]); o[j] = x[4 * i + j]; }
                *(f32x4*)(xd + c) = o; }
        }
        if (Hout) {
            float ss = 0.f;
#pragma unroll
            for (int i = 0; i < 16; ++i) ss += x[i] * x[i];
            ss = wave_sum(ss);
            const float rstd = rsqrtf(ss * (1.f / 1024.f) + 1e-6f);
#pragma unroll
            for (int i = 0; i < 4; ++i) { const int c = i * 256 + lane * 4; const f32x4 np = *(const f32x4*)(norm_pre + c); const f32x4 sh = *(const f32x4*)(mdp + shift_idx * 1024 + c); const f32x4 sc = *(const f32x4*)(mdp + scale_idx * 1024 + c);
                float h[4];
#pragma unroll
                for (int j = 0; j < 4; ++j) h[j] = x[4 * i + j] * rstd * np[j] * (1.f + sc[j]) + sh[j];
                u32x2 o; o[0] = cvt_pk_bf16(h[0], h[1]); o[1] = cvt_pk_bf16(h[2], h[3]);
                bf16_t* hp = (Hctx && n >= NLAT) ? Hctx + (size_t)(n - NLAT) * DM : Hout + (size_t)n * DM;
                *(u32x2*)(hp + c) = o; }
        }
    };
    const int stride = gridDim.x * 8;
    for (int n = blockIdx.x * 8 + wave; n < nrows; n += 2 * stride) {
        const int n1 = n + stride; const bool has1 = n1 < nrows;
        float xa[16], ya[16], xb[16], yb[16];
        load_row(n, xa, ya); if (has1) load_row(n1, xb, yb);
        finish_row(n, xa, ya); if (has1) finish_row(n1, xb, yb);
    }
}

constexpr int GS = 72;
constexpr int L_QDF = 0, L_QDB = 9216, L_KIF = 18432, L_KIB = 27648, L_VT = 36864, L_KEF = 55296, L_KEB = 64512, L_STF = 73728, L_STB = 92160, L_CUMF = 73728, L_CUMB = 90112, L_ALD = 106496, L_OX = 0;
constexpr int L_RAW = 110592, L_TOT = 144384;
struct GlaRaw { u32x4 v[5]; u32x4 a; };
__device__ __forceinline__ void gla_issue(const PR& p, int l, int cid, int h, GlaRaw& g) {
    const bf16_t* P = (const bf16_t*)(p.ws + OFF_ARENA + A_P);
    const int colorder = !(l & 1);
    const int s = (cid < 256) ? (cid >> 6) : 4 + ((cid - 256) >> 2), nch = (cid < 256) ? (cid & 63) : ((cid - 256) & 3), T = (s < 4) ? SEQ : CTX, p0 = nch * 64;
    const int tid = otid();
#pragma unroll
    for (int k = 0; k < 5; ++k) {
        const int e = tid + k * NTHREADS;
        const int r = e >> 5, c16 = e & 31, pp = p0 - 1 + r, ch0 = c16 * 8;
        const int col = (ch0 < 64) ? (P_GQ + h * 64 + ch0) : (ch0 < 128) ? (P_GK + h * 64 + (ch0 - 64)) : (P_GV + h * 128 + (ch0 - 128));
        u32x4 v = {0u, 0u, 0u, 0u};
        if (e < 66 * 32 && pp >= 0 && pp < T) v = *(const u32x4*)(P + (size_t)tok_of(s, pp, colorder) * LDP + col);
        g.v[k] = v;
    }
    g.a = (u32x4){0u, 0u, 0u, 0u};
    if (tid < 256) { const int r = tid >> 2, c = tid & 3; g.a = *(const u32x4*)(P + (size_t)tok_of(s, p0 + r, colorder) * LDP + P_ALF + c * 8); }
}
__device__ __forceinline__ void gla_stage(const PR& p, unsigned char* shm, int l, int cid, int h, bool need_qd, const GlaRaw& g) {
    const bf16_t* P = (const bf16_t*)(p.ws + OFF_ARENA + A_P);
    const int colorder = !(l & 1);
    const int s = (cid < 256) ? (cid >> 6) : 4 + ((cid - 256) >> 2), nch = (cid < 256) ? (cid & 63) : ((cid - 256) & 3), T = (s < 4) ? SEQ : CTX, p0 = nch * 64;
    const int tid = otid();
    float* cumF = (float*)(shm + L_CUMF); float* cumB = (float*)(shm + L_CUMB); const bf16_t* ald = (const bf16_t*)(shm + L_ALD); float* tot = (float*)(shm + L_TOT);
    const bf16_t* raw = (const bf16_t*)(shm + L_RAW);
    __syncthreads();
#pragma unroll
    for (int k = 0; k < 5; ++k) { const int e = tid + k * NTHREADS; if (e < 66 * 32) *(u32x4*)(shm + L_RAW + ((e >> 5) * 256 + (e & 31) * 8) * 2) = g.v[k]; }
    if (tid < 256) *(u32x4*)(shm + L_ALD + ((tid >> 2) * 32 + (tid & 3) * 8) * 2) = g.a;
    __syncthreads();
    const int key = tid & 63, d = (tid >> 6) & 1, tg = tid >> 7;
    float la[16];
    {
        const float* up = p.in[I_ALUP] + ((size_t)(l * 2 + d) * 16) * 256 + h * 64 + key; const float bias = p.in[I_ALB][(l * 2 + d) * 256 + h * 64 + key];
        typedef __bf16 hbf8_t __attribute__((ext_vector_type(8)));
        hbf2_t wp[8];
#pragma unroll
        for (int k = 0; k < 8; ++k) { const hf2_t w2 = {up[(size_t)(2 * k) * 256], up[(size_t)(2 * k + 1) * 256]}; wp[k] = __builtin_convertvector(w2, hbf2_t); }
#pragma unroll
        for (int i = 0; i < 16; ++i) {
            const hbf8_t x0 = *(const hbf8_t*)(ald + (tg * 16 + i) * 32 + d * 16), x1 = *(const hbf8_t*)(ald + (tg * 16 + i) * 32 + d * 16 + 8);
            float a = bias;
            a = __builtin_amdgcn_fdot2_f32_bf16(__builtin_shufflevector(x0, x0, 0, 1), wp[0], a, false);
            a = __builtin_amdgcn_fdot2_f32_bf16(__builtin_shufflevector(x0, x0, 2, 3), wp[1], a, false);
            a = __builtin_amdgcn_fdot2_f32_bf16(__builtin_shufflevector(x0, x0, 4, 5), wp[2], a, false);
            a = __builtin_amdgcn_fdot2_f32_bf16(__builtin_shufflevector(x0, x0, 6, 7), wp[3], a, false);
            a = __builtin_amdgcn_fdot2_f32_bf16(__builtin_shufflevector(x1, x1, 0, 1), wp[4], a, false);
            a = __builtin_amdgcn_fdot2_f32_bf16(__builtin_shufflevector(x1, x1, 2, 3), wp[5], a, false);
            a = __builtin_amdgcn_fdot2_f32_bf16(__builtin_shufflevector(x1, x1, 4, 5), wp[6], a, false);
            a = __builtin_amdgcn_fdot2_f32_bf16(__builtin_shufflevector(x1, x1, 6, 7), wp[7], a, false);
            la[i] = -(fmaxf(-a, 0.f) + __logf(1.f + __expf(-fabsf(a)))) * (1.f / 16.f);
        }
        if (d == 0) {
#pragma unroll
            for (int i = 1; i < 16; ++i) la[i] += la[i - 1];
            tot[(0 * 4 + tg) * 64 + key] = la[15];
        } else {
#pragma unroll
            for (int i = 14; i >= 0; --i) la[i] += la[i + 1];
            tot[(1 * 4 + tg) * 64 + key] = la[0];
        }
    }
    __syncthreads();
    {
        float off = 0.f;
#pragma unroll
        for (int g = 0; g < 4; ++g) { const float t = tot[(d * 4 + g) * 64 + key]; off += (d == 0 ? (g < tg) : (g > tg)) ? t : 0.f; }
        float* dst = d ? cumB : cumF;
#pragma unroll
        for (int i = 0; i < 16; ++i) dst[(tg * 16 + i) * 64 + key] = la[i] + off;
    }
    __syncthreads();
    {
        const int ch = tid & 255, th = tid >> 8;
        const int cc = (ch < 64) ? (h * 64 + ch) : (ch < 128) ? (256 + h * 64 + (ch - 64)) : (512 + h * 128 + (ch - 128));
        const float* cw = p.in[I_CONV] + (size_t)l * 3 * 1024; const float w0 = cw[cc], w1 = cw[1024 + cc], w2 = cw[2048 + cc];
        const int i0 = th * 32;
        float fm = bf2f(raw[(i0) * 256 + ch]), f0 = bf2f(raw[(i0 + 1) * 256 + ch]);
        bf16_t* qdF = (bf16_t*)(shm + L_QDF); bf16_t* qdB = (bf16_t*)(shm + L_QDB); bf16_t* kiF = (bf16_t*)(shm + L_KIF); bf16_t* kiB = (bf16_t*)(shm + L_KIB);
        bf16_t* vT = (bf16_t*)(shm + L_VT); bf16_t* keF = (bf16_t*)(shm + L_KEF); bf16_t* keB = (bf16_t*)(shm + L_KEB);
        const float totF = (ch >= 64 && ch < 128) ? cumF[63 * 64 + (ch - 64)] : 0.f, totB = (ch >= 64 && ch < 128) ? cumB[ch - 64] : 0.f;
#pragma unroll 4
        for (int i = i0; i < i0 + 32; ++i) {
            const float fp = bf2f(raw[(i + 2) * 256 + ch]);
            const float y = siluf(w0 * fm + w1 * f0 + w2 * fp);
            fm = f0; f0 = fp;
            if (ch < 64) { if (need_qd) { const float q = y * 0.125f; qdF[i * GS + ch] = f2bf(q * __expf(cumF[i * 64 + ch])); qdB[i * GS + ch] = f2bf(q * __expf(cumB[i * 64 + ch])); } }
            else if (ch < 128) { const int kx = ch - 64; const float cf = cumF[i * 64 + kx], cb = cumB[i * 64 + kx];
                if (need_qd) { kiF[i * GS + kx] = f2bf(y * __expf(-cf)); kiB[i * GS + kx] = f2bf(y * __expf(-cb)); }
                else { keF[kx * GS + i] = f2bf(y * __expf(totF - cf)); keB[kx * GS + i] = f2bf(y * __expf(totB - cb)); } }
            else vT[(ch - 128) * GS + i] = f2bf(y);
        }
    }
    __syncthreads();
}
__device__ __forceinline__ bf16x8 lds_frag(const unsigned char* shm, int off, int row, int col) { return *(const bf16x8*)(shm + off + (row * GS + col) * 2); }

__device__ __forceinline__ void ph_gla_a(const PR& p, unsigned char* shm, int l) {
    bf16_t* KV = (bf16_t*)(p.ws + OFF_ARENA + A_KV); float* gdec = (float*)(p.ws + OFF_GDEC);
    const int wave = otid() >> 6, lane = otid() & 63, fr = lane & 15, fq = lane >> 4;
    GlaRaw graw; if (blockIdx.x < 272 * 4) gla_issue(p, l, blockIdx.x >> 2, blockIdx.x & 3, graw);
    for (int it = blockIdx.x; it < 272 * 4; it += gridDim.x) {
        const int cid = it >> 2, h = it & 3;
        gla_stage(p, shm, l, cid, h, false, graw);
        { const int itn = it + gridDim.x; if (itn < 272 * 4) gla_issue(p, l, itn >> 2, itn & 3, graw); }
        const bf16x8 a0 = lds_frag(shm, L_VT, wave * 16 + fr, fq * 8), a1 = lds_frag(shm, L_VT, wave * 16 + fr, 32 + fq * 8);
#pragma unroll
        for (int d = 0; d < 2; ++d)
#pragma unroll
            for (int nt = 0; nt < 4; ++nt) {
                const int off = d ? L_KEB : L_KEF;
                const bf16x8 b0 = lds_frag(shm, off, nt * 16 + fr, fq * 8), b1 = lds_frag(shm, off, nt * 16 + fr, 32 + fq * 8);
                f32x4 c = {0.f, 0.f, 0.f, 0.f};
                c = __builtin_amdgcn_mfma_f32_16x16x32_bf16(a0, b0, c, 0, 0, 0);
                c = __builtin_amdgcn_mfma_f32_16x16x32_bf16(a1, b1, c, 0, 0, 0);
                bf16_t* o = KV + ((size_t)(it * 2 + d) * 128) * 64;
#pragma unroll
                for (int j = 0; j < 4; ++j) o[(wave * 16 + fq * 4 + j) * 64 + nt * 16 + fr] = f2bf(c[j]);
            }
        if (otid() < 128) { const int d = otid() >> 6, key = otid() & 63; const float* cum = (const float*)(shm + (d ? L_CUMB : L_CUMF));
            gdec[(size_t)(it * 2 + d) * 64 + key] = __expf(d ? cum[key] : cum[63 * 64 + key]); }
    }
}
__device__ __forceinline__ void ph_gla_b(const PR& p) {
    unsigned* KV = (unsigned*)(p.ws + OFF_ARENA + A_KV); const float* gdec = (const float*)(p.ws + OFF_GDEC);
    for (int e = blockIdx.x * NTHREADS + otid(); e < 32 * 4096; e += gridDim.x * NTHREADS) {
        const int combo = e >> 12, pe = e & 4095;
        const int b = combo >> 3, h = (combo >> 1) & 3, d = combo & 1, key = (pe & 31) * 2;
        float s0 = 0.f, s1 = 0.f;
#pragma unroll
        for (int hb = 0; hb < 2; ++hb) {
            unsigned kv[34]; float d0[34], d1[34]; unsigned* ptr[34];
#pragma unroll
            for (int j = 0; j < 34; ++j) {
                const int i = hb * 34 + j;
                int cid; if (i < 4) cid = 256 + b * 4 + (d ? 3 - i : i); else cid = b * 64 + (d ? 63 - (i - 4) : (i - 4));
                const size_t ent = (size_t)((cid * 4 + h) * 2 + d);
                ptr[j] = KV + ent * 4096 + pe; kv[j] = *ptr[j]; d0[j] = gdec[ent * 64 + key]; d1[j] = gdec[ent * 64 + key + 1];
            }
#pragma unroll
            for (int j = 0; j < 34; ++j) {
                *ptr[j] = cvt_pk_bf16(s0, s1);
                s0 = s0 * d0[j] + lo_bf(kv[j]); s1 = s1 * d1[j] + hi_bf(kv[j]);
            }
        }
    }
}
__device__ __forceinline__ void ph_gla_c(const PR& p, unsigned char* shm, int l) {
    const bf16_t* P = (const bf16_t*)(p.ws + OFF_ARENA + A_P); const bf16_t* KV = (const bf16_t*)(p.ws + OFF_ARENA + A_KV); bf16_t* YG = (bf16_t*)(p.ws + OFF_ARENA + A_YG);
    const int colorder = !(l & 1);
    const int wave = otid() >> 6, lane = otid() & 63, fr = lane & 15, fq = lane >> 4;
    GlaRaw graw; if (blockIdx.x < 272 * 4) gla_issue(p, l, blockIdx.x >> 2, blockIdx.x & 3, graw);
    for (int it = blockIdx.x; it < 272 * 4; it += gridDim.x) {
        if (l == 1 && it >= 256 * 4) break;
        const int cid = it >> 2, h = it & 3;
        const int s = (cid < 256) ? (cid >> 6) : 4 + ((cid - 256) >> 2), nch = (cid < 256) ? (cid & 63) : ((cid - 256) & 3), p0 = nch * 64;
        gla_stage(p, shm, l, cid, h, true, graw);
        { const int itn = it + gridDim.x; if (itn < 272 * 4) gla_issue(p, l, itn >> 2, itn & 3, graw); }
        for (int e = otid(); e < 2 * 128 * 8; e += NTHREADS) { const int d = e >> 10, r = (e >> 3) & 127, c8 = e & 7;
            const u32x4 v = *(const u32x4*)(KV + ((size_t)(it * 2 + d) * 128 + r) * 64 + c8 * 8);
            *(u32x4*)(shm + (d ? L_STB : L_STF) + (r * GS + c8 * 8) * 2) = v; }
        {
            const int d = wave >> 2, mt = wave & 3; const int qoff = d ? L_QDB : L_QDF, koff = d ? L_KIB : L_KIF, poff = d ? L_KEB : L_KEF;
            const bf16x8 a0 = lds_frag(shm, qoff, mt * 16 + fr, fq * 8), a1 = lds_frag(shm, qoff, mt * 16 + fr, 32 + fq * 8);
            bf16_t* Pm = (bf16_t*)(shm + poff);
#pragma unroll
            for (int nt = 0; nt < 4; ++nt) {
                const bf16x8 b0 = lds_frag(shm, koff, nt * 16 + fr, fq * 8), b1 = lds_frag(shm, koff, nt * 16 + fr, 32 + fq * 8);
                f32x4 c = {0.f, 0.f, 0.f, 0.f};
                c = __builtin_amdgcn_mfma_f32_16x16x32_bf16(a0, b0, c, 0, 0, 0);
                c = __builtin_amdgcn_mfma_f32_16x16x32_bf16(a1, b1, c, 0, 0, 0);
#pragma unroll
                for (int j = 0; j < 4; ++j) { const int i = mt * 16 + fq * 4 + j, jj = nt * 16 + fr; const bool keep = d ? (jj >= i) : (jj <= i); Pm[i * GS + jj] = f2bf(keep ? c[j] : 0.f); }
            }
        }
        __syncthreads();
        f32x4 acc[8];
        {
            const int d = wave >> 2, mt = wave & 3; const int qoff = d ? L_QDB : L_QDF, poff = d ? L_KEB : L_KEF, soff = d ? L_STB : L_STF;
            const bf16x8 pa0 = lds_frag(shm, poff, mt * 16 + fr, fq * 8), pa1 = lds_frag(shm, poff, mt * 16 + fr, 32 + fq * 8);
            const bf16x8 qa0 = lds_frag(shm, qoff, mt * 16 + fr, fq * 8), qa1 = lds_frag(shm, qoff, mt * 16 + fr, 32 + fq * 8);
#pragma unroll
            for (int nt = 0; nt < 8; ++nt) {
                f32x4 c = {0.f, 0.f, 0.f, 0.f};
                c = __builtin_amdgcn_mfma_f32_16x16x32_bf16(pa0, lds_frag(shm, L_VT, nt * 16 + fr, fq * 8), c, 0, 0, 0);
                c = __builtin_amdgcn_mfma_f32_16x16x32_bf16(pa1, lds_frag(shm, L_VT, nt * 16 + fr, 32 + fq * 8), c, 0, 0, 0);
                c = __builtin_amdgcn_mfma_f32_16x16x32_bf16(qa0, lds_frag(shm, soff, nt * 16 + fr, fq * 8), c, 0, 0, 0);
                c = __builtin_amdgcn_mfma_f32_16x16x32_bf16(qa1, lds_frag(shm, soff, nt * 16 + fr, 32 + fq * 8), c, 0, 0, 0);
                acc[nt] = c;
            }
        }
        __syncthreads();
        float* ox = (float*)(shm + L_OX);
        if (wave >= 4) { const int mt = wave & 3;
#pragma unroll
            for (int nt = 0; nt < 8; ++nt)
#pragma unroll
                for (int j = 0; j < 4; ++j) ox[(mt * 16 + fq * 4 + j) * 128 + nt * 16 + fr] = acc[nt][j]; }
        __syncthreads();
        if (wave < 4) { const int mt = wave;
            float ss[4] = {0.f, 0.f, 0.f, 0.f};
#pragma unroll
            for (int nt = 0; nt < 8; ++nt)
#pragma unroll
                for (int j = 0; j < 4; ++j) { acc[nt][j] += ox[(mt * 16 + fq * 4 + j) * 128 + nt * 16 + fr]; ss[j] += acc[nt][j] * acc[nt][j]; }
#pragma unroll
            for (int j = 0; j < 4; ++j) {
                const float tot = row16_sum(ss[j]); const float rstd = rsqrtf(tot * (1.f / 128.f) + 1e-6f);
                const int i = mt * 16 + fq * 4 + j; const int n = tok_of(s, p0 + i, colorder);
#pragma unroll
                for (int nt = 0; nt < 8; ++nt) { const int col = nt * 16 + fr; const float gate = bf2f(P[(size_t)n * LDP + P_GG + h * 128 + col]);
                    YG[(size_t)n * 512 + h * 128 + col] = f2bf(acc[nt][j] * rstd * p.in[I_GNORM][l * 128 + col] * siluf(gate)); }
            }
        }
    }
}

__device__ __forceinline__ void ph_rw_prep(const PR& p, int l) {
    const bf16_t* P = (const bf16_t*)(p.ws + OFF_ARENA + A_P); bf16_t* RKV = (bf16_t*)(p.ws + OFF_ARENA + A_RKVS); bf16_t* AS = (bf16_t*)(p.ws + OFF_ARENA + A_AS);
    bf16_t* VF = (bf16_t*)(p.ws + OFF_VF); float* kinv = (float*)(p.ws + OFF_KINV);
    const int colorder = (l & 1), tid = otid(), wave = tid >> 6, lane = tid & 63;
    const float* mu = p.in[I_MU] + (size_t)l * 1920; const float* kkw = p.in[I_KK] + (size_t)l * 512;
    for (int n = blockIdx.x * 8 + wave; n < NTOK; n += gridDim.x * 8) {
        int s, pos, T;
        if (n < NLAT) { s = n >> 12; const int t = n & 4095; pos = colorder ? (((t & 63) << 6) | (t >> 6)) : t; T = SEQ; } else { s = 4 + ((n - NLAT) >> 8); pos = (n - NLAT) & 255; T = CTX; }
        const bool hp = pos > 0, hn = pos < T - 1;
        const bf16_t* r0 = P + (size_t)n * LDP; const bf16_t* rp = P + (size_t)(hp ? tok_of(s, pos - 1, colorder) : n) * LDP; const bf16_t* rn = P + (size_t)(hn ? tok_of(s, pos + 1, colorder) : n) * LDP;
        const float wp = hp ? 0.5f : 0.f, wn = hn ? 0.5f : 0.f;
#pragma unroll
        for (int j = 0; j < 15; ++j) {
            const int c = j * 128 + lane * 2;
            const unsigned u0 = *(const unsigned*)(r0 + c), up = *(const unsigned*)(rp + c), un = *(const unsigned*)(rn + c);
            const hf2_t m2 = *(const hf2_t*)(mu + c);
            const float f0 = lo_bf(u0), f1 = hi_bf(u0);
            const float s0 = f0 + m2[0] * (wp * lo_bf(up) + wn * lo_bf(un) - f0), s1 = f1 + m2[1] * (wp * hi_bf(up) + wn * hi_bf(un) - f1);
            if (j < 12) {
                *(unsigned*)(RKV + (size_t)n * 1536 + c) = cvt_pk_bf16(s0, s1);
                if (j >= 4 && j < 8) { const hf2_t k2 = *(const hf2_t*)(kkw + (c - 512)); const float t0 = s0 * k2[0], t1 = s1 * k2[1]; float ss = t0 * t0 + t1 * t1;
#pragma unroll
                    for (int o = 16; o > 0; o >>= 1) ss += __shfl_xor(ss, o);
                    if ((lane & 31) == 0) kinv[(size_t)n * 8 + (j - 4) * 2 + (lane >> 5)] = rsqrtf(ss + 1e-12f); }
                if (j >= 8 && l == 0) *(unsigned*)(VF + (size_t)n * 512 + (c - 1024)) = cvt_pk_bf16(s0, s1);
            } else {
                float o0, o1;
                if (j == 12) { o0 = tanhf(s0); o1 = tanhf(s1); } else if (j == 13) { o0 = s0; o1 = s1; } else { o0 = sigm(s0); o1 = sigm(s1); }
                *(unsigned*)(AS + (size_t)n * 384 + (c - 1536)) = cvt_pk_bf16(o0, o1);
            }
        }
    }
}

constexpr int SC_T = 32;
constexpr int SC_BUF = 5 * SC_T * 64 * 4 + 4 * 64 * 4;
__device__ __forceinline__ void ph_rw_scan(const PR& p, unsigned char* shm, int l) {
    const bf16_t* RKV = (const bf16_t*)(p.ws + OFF_ARENA + A_RKVS); const bf16_t* LR = (const bf16_t*)(p.ws + OFF_ARENA + A_LR); const float* kinv = (const float*)(p.ws + OFF_KINV);
    float* bon = (float*)(p.ws + OFF_BON); bf16_t* YF = (bf16_t*)(p.ws + OFF_ARENA + A_YF); bf16_t* YB = (bf16_t*)(p.ws + OFF_ARENA + A_YB);
    const int colorder = (l & 1), tid = otid(), lane = tid & 63;
    for (int it = blockIdx.x; it < 256; it += gridDim.x) {
        const int rq = it & 3, d = (it >> 2) & 1, h = (it >> 3) & 7, b = it >> 6;
        bf16_t* Yd = d ? YB : YF;
        __syncthreads();
        const bool loader = tid >= 256;
        const int ch = lane, sg = (tid >> 6) & 3, cidx = h * 64 + ch;
        const float k_k = p.in[I_KK][l * 512 + cidx], k_a = p.in[I_KA][l * 512 + cidx], r_k = p.in[I_RK][l * 512 + cidx];
        const int cw = tid >> 6, rowg = lane >> 4, ks = lane & 15, row = rq * 16 + cw * 4 + rowg;
        hf2_t sA = {0.f, 0.f}, sB = {0.f, 0.f};
        constexpr int NCH = (CTX + SEQ) / SC_T;
        bf16_t rr[8], rk[8], rv[8], rw[8], ra[8]; float rki[8]; int rn[8];
        auto issue = [&](int chunk) {
            const int gs0 = chunk * SC_T + sg * 8;
            int n0; if (gs0 < CTX) n0 = tok_of(4 + b, d ? (CTX - 1 - gs0) : gs0, 0); else { const int qq = gs0 - CTX; n0 = tok_of(b, d ? (SEQ - 1 - qq) : qq, colorder); }
            const int dn = ((gs0 >= CTX) && colorder) ? (d ? -64 : 64) : (d ? -1 : 1);
            const bf16_t* rp0 = RKV + (size_t)n0 * 1536 + cidx; const bf16_t* lp0 = LR + (size_t)n0 * 2048 + d * 512 + cidx; const float* kp0 = kinv + (size_t)n0 * 8 + h;
            const long drp = (long)dn * 1536, dlp = (long)dn * 2048, dkp = (long)dn * 8;
#pragma unroll
            for (int q = 0; q < 8; ++q) {
                rn[q] = n0 + q * dn;
                const bf16_t* rp = rp0 + q * drp; const bf16_t* lp = lp0 + q * dlp;
                rr[q] = rp[0]; rk[q] = rp[512]; rv[q] = rp[1024]; rw[q] = lp[0]; ra[q] = lp[1024]; rki[q] = kp0[q * dkp];
            }
        };
        auto process = [&](int chunk) {
            unsigned char* buf = shm + (chunk & 1) * SC_BUF;
            float* Kr = (float*)buf; float* Kk = Kr + SC_T * 64; float* Ka = Kk + SC_T * 64; float* Rr = Ka + SC_T * 64; float* Vv = Rr + SC_T * 64; float* Dg = Vv + SC_T * 64;
            float P = 0.f, Dprev = 1.f;
#pragma unroll
            for (int q = 0; q < 8; ++q) {
                const int st = sg * 8 + q, n = rn[q];
                const float r = bf2f(rr[q]), k = bf2f(rk[q]), v = bf2f(rv[q]);
                P += bf2f(rw[q]);
                const float D = __expf(-P), iD = __expf(P);
                const float a = bf2f(ra[q]);
                const float krep = k * (1.f + (a - 1.f) * k_a);
                const float kk = k * k_k * rki[q];
                Kr[st * 64 + ch] = krep * iD; Kk[st * 64 + ch] = kk * Dprev; Ka[st * 64 + ch] = kk * a * iD; Rr[st * 64 + ch] = r * D; Vv[st * 64 + ch] = v;
                Dprev = D;
                if ((q & 3) == rq) {
                    const float bsum = wave_sum(r * krep * r_k);
                    if (ch == 0) bon[((size_t)d * NTOK + n) * 8 + h] = bsum; }
            }
            Dg[sg * 64 + ch] = Dprev;
        };
        auto yreduce = [&](int chunk) {
            const float* yb = (const float*)(shm + 2 * SC_BUF + (chunk & 1) * 16384);
#pragma unroll
            for (int o2 = 0; o2 < 2; ++o2) {
                const int o = (tid - 256) + o2 * 256, st = o >> 4, rowl = o & 15, gs = chunk * SC_T + st;
                int n;
                if (gs < CTX) n = tok_of(4 + b, d ? (CTX - 1 - gs) : gs, 0); else { const int qq = gs - CTX; n = tok_of(b, d ? (SEQ - 1 - qq) : qq, colorder); }
                const f32x4 y0 = *(const f32x4*)(yb + o * 8), y1 = *(const f32x4*)(yb + o * 8 + 4);
                const float y = ((y0[0] + y0[1]) + (y0[2] + y0[3])) + ((y1[0] + y1[1]) + (y1[2] + y1[3]));
                Yd[(size_t)n * 512 + h * 64 + rq * 16 + rowl] = f2bf(y);
            }
        };
        if (loader) { issue(0); process(0); issue(1); }
        __syncthreads();
        for (int c = 0; c < NCH; ++c) {
            if (loader) { if (c + 1 < NCH) { process(c + 1); if (c + 2 < NCH) issue(c + 2); } if (c >= 1) yreduce(c - 1); }
            else {
                const unsigned char* buf = shm + (c & 1) * SC_BUF;
                const float* Kr = (const float*)buf; const float* Kk = Kr + SC_T * 64; const float* Ka = Kk + SC_T * 64; const float* Rr = Ka + SC_T * 64; const float* Vv = Rr + SC_T * 64; const float* Dg = Vv + SC_T * 64;
                f32x4 pkr[3], pkk[3], pka[3], pr[3]; float pv[3];
                f32x4 dg[4];
#pragma unroll
                for (int g = 0; g < 4; ++g) dg[g] = *(const f32x4*)(Dg + g * 64 + ks * 4);
                float* ybw = (float*)(shm + 2 * SC_BUF + (c & 1) * 16384) + (cw * 4 + rowg) * 8 + (ks & 7);
#define SC_LOAD(slot, st_) do { const int _o = (st_) * 64 + ks * 4; pkr[slot] = *(const f32x4*)(Kr + _o); pkk[slot] = *(const f32x4*)(Kk + _o); \
                    pka[slot] = *(const f32x4*)(Ka + _o); pr[slot] = *(const f32x4*)(Rr + _o); pv[slot] = Vv[(st_) * 64 + row]; } while (0)
                SC_LOAD(0, 0); SC_LOAD(1, 1);
#pragma unroll
                for (int st = 0; st < SC_T; ++st) {
                    const int cs = st % 3, ns = (st + 2) % 3;
                    if (st + 2 < SC_T) SC_LOAD(ns, st + 2);
                    __builtin_amdgcn_sched_barrier(0x6);
                    const f32x4 kr4 = pkr[cs], kk4 = pkk[cs], ka4 = pka[cs], r4 = pr[cs]; const float v = pv[cs];
                    const hf2_t t2 = sA * kk4.lo + sB * kk4.hi;
                    const float sa = row16_sum(t2[0] + t2[1]);
                    const hf2_t vv = {v, v}, nsa = {-sa, -sa};
                    sA = sA + vv * kr4.lo + nsa * ka4.lo;
                    sB = sB + vv * kr4.hi + nsa * ka4.hi;
                    const hf2_t u2 = sA * r4.lo + sB * r4.hi;
                    float yp = u2[0] + u2[1]; yp += dppf<0x128>(yp);
                    ybw[st * 128] = yp;
                    if ((st & 7) == 7) { sA *= dg[st >> 3].lo; sB *= dg[st >> 3].hi; }
                }
#undef SC_LOAD
            }
            __syncthreads();
        }
        if (loader) yreduce(NCH - 1);
    }
}

__device__ __forceinline__ void ph_rw_post(const PR& p, int l, int ntok) {
    bf16_t* YF = (bf16_t*)(p.ws + OFF_ARENA + A_YF); const bf16_t* YB = (const bf16_t*)(p.ws + OFF_ARENA + A_YB); const bf16_t* RKV = (const bf16_t*)(p.ws + OFF_ARENA + A_RKVS);
    const bf16_t* G = (const bf16_t*)(p.ws + OFF_ARENA + A_G); const float* bon = (const float*)(p.ws + OFF_BON);
    const int tid = otid(), wave = tid >> 6, lane = tid & 63, c0 = lane * 8, h = lane >> 3;
    float gw[8], gb[8];
#pragma unroll
    for (int j = 0; j < 8; ++j) { gw[j] = p.in[I_GNW][l * 512 + c0 + j]; gb[j] = p.in[I_GNB][l * 512 + c0 + j]; }
    for (int n = blockIdx.x * 8 + wave; n < ntok; n += gridDim.x * 8) {
        const u32x4 yf = *(const u32x4*)(YF + (size_t)n * 512 + c0), yb = *(const u32x4*)(YB + (size_t)n * 512 + c0), vv = *(const u32x4*)(RKV + (size_t)n * 1536 + 1024 + c0), gg = *(const u32x4*)(G + (size_t)n * 512 + c0);
        const float bs = bon[(size_t)n * 8 + h] + bon[((size_t)NTOK + n) * 8 + h];
        float y[8]; float sum = 0.f;
#pragma unroll
        for (int j = 0; j < 4; ++j) { y[2 * j] = lo_bf(yf[j]) + lo_bf(yb[j]); y[2 * j + 1] = hi_bf(yf[j]) + hi_bf(yb[j]); sum += y[2 * j] + y[2 * j + 1]; }
        sum += __shfl_xor(sum, 1); sum += __shfl_xor(sum, 2); sum += __shfl_xor(sum, 4);
        const float mean = sum * (1.f / 64.f);
        float vs = 0.f;
#pragma unroll
        for (int j = 0; j < 8; ++j) { y[j] -= mean; vs += y[j] * y[j]; }
        vs += __shfl_xor(vs, 1); vs += __shfl_xor(vs, 2); vs += __shfl_xor(vs, 4);
        const float rstd = rsqrtf(vs * (1.f / 64.f) + 64e-5f);
        float o[8];
#pragma unroll
        for (int j = 0; j < 4; ++j) {
            o[2 * j] = (y[2 * j] * rstd * gw[2 * j] + gb[2 * j] + bs * lo_bf(vv[j])) * lo_bf(gg[j]);
            o[2 * j + 1] = (y[2 * j + 1] * rstd * gw[2 * j + 1] + gb[2 * j + 1] + bs * hi_bf(vv[j])) * hi_bf(gg[j]); }
        u32x4 w; w.x = cvt_pk_bf16(o[0], o[1]); w.y = cvt_pk_bf16(o[2], o[3]); w.z = cvt_pk_bf16(o[4], o[5]); w.w = cvt_pk_bf16(o[6], o[7]);
        *(u32x4*)(YF + (size_t)n * 512 + c0) = w;
    }
}


#define XB_TMO      128
#define XB_XCNT(j)  (256  + 64 * (j))
#define XB_XSUB(j)  (1280 + 64 * (j))
#define XB_XGEN(j)  (2304 + 64 * (j))
#define XB_TOP      3328
#define XB_TOPGEN   3392
#define XCD_BAR_WORDS 3456
#define XB_SPIN_CAP (1u << 18)
__device__ __forceinline__ unsigned xb_ld(unsigned* p)              { return __hip_atomic_load(p, __ATOMIC_RELAXED, __HIP_MEMORY_SCOPE_AGENT); }
__device__ __forceinline__ unsigned xb_add(unsigned* p, unsigned v) { return __hip_atomic_fetch_add(p, v, __ATOMIC_RELAXED, __HIP_MEMORY_SCOPE_AGENT); }
__device__ __forceinline__ unsigned xb_xcc_id() { return (unsigned)__builtin_amdgcn_s_getreg((3 << 11) | 20) & 0xFu; }
#define XB_SPIN(cond, bar) do { unsigned _sp = 0; while (cond) { __builtin_amdgcn_s_sleep(1); \
    if ((++_sp & 255u) == 0u) { if (xb_ld(&(bar)[XB_TMO])) break; if (_sp > XB_SPIN_CAP) { atomicAdd(&(bar)[XB_TMO], 1u); break; } } } } while (0)
struct XcdBarrier { unsigned* bar; unsigned x; volatile LAS unsigned* st; };
__device__ __forceinline__ XcdBarrier xcd_barrier_post(unsigned* bar, volatile LAS unsigned* st) {
    XcdBarrier b; b.bar = bar; b.x = xb_xcc_id(); b.st = st;
    if (threadIdx.x == 0) (void)xb_add(&bar[XB_XCNT(b.x)], 1u);
    return b;
}
__device__ __forceinline__ void xcd_barrier_complete(unsigned* bar, unsigned x, unsigned& nloc, unsigned& nx) {
    const unsigned G = gridDim.x * gridDim.y * gridDim.z;
    unsigned sum, cnt, mine, sp = 0u;
    for (;;) {
        sum = 0u; cnt = 0u; mine = 0u;
#pragma unroll
        for (unsigned j = 0; j < 16; ++j) { const unsigned c = xb_ld(&bar[XB_XCNT(j)]); sum += c; cnt += (c > 0u) ? 1u : 0u; mine = (j == x) ? c : mine; }
        if (sum == G) break;
        __builtin_amdgcn_s_sleep(1);
        if ((++sp & 255u) == 0u) { if (xb_ld(&bar[XB_TMO])) break; if (sp > XB_SPIN_CAP) { atomicAdd(&bar[XB_TMO], 1u); break; } }
    }
    nloc = mine > 0u ? mine : 1u; nx = cnt > 0u ? cnt : 1u;
}
__device__ __forceinline__ void xcd_barrier(const XcdBarrier& b) {
    asm volatile("s_waitcnt vmcnt(0)" ::: "memory");
    __syncthreads();
    if (threadIdx.x == 0) {
        unsigned* bar = b.bar;
        __builtin_amdgcn_s_waitcnt(0);
        unsigned nloc = b.st[0], nx = b.st[1];
        if (nloc == 0u) { xcd_barrier_complete(bar, b.x, nloc, nx); b.st[0] = nloc; b.st[1] = nx; }
        const unsigned old = xb_add(&bar[XB_XSUB(b.x)], 1u);
        const unsigned gen = old / nloc;
        if (old + 1u == (gen + 1u) * nloc) {
            __builtin_amdgcn_fence(__ATOMIC_RELEASE, "agent");
            asm volatile("s_waitcnt vmcnt(0)" ::: "memory");
            const unsigned og = xb_add(&bar[XB_TOP], 1u);
            const unsigned tg = og / nx;
            if (og + 1u == (tg + 1u) * nx) xb_add(&bar[XB_TOPGEN], 1u);
            else XB_SPIN(xb_ld(&bar[XB_TOPGEN]) == tg, bar);
            __builtin_amdgcn_fence(__ATOMIC_ACQUIRE, "agent");
            xb_add(&bar[XB_XGEN(b.x)], 1u);
            asm volatile("s_waitcnt vmcnt(0)" ::: "memory");
        } else {
            XB_SPIN(xb_ld(&bar[XB_XGEN(b.x)]) == gen, bar);
            __builtin_amdgcn_fence(__ATOMIC_ACQUIRE, "agent");
            asm volatile("s_waitcnt vmcnt(0)" ::: "memory");
        }
    }
    __syncthreads();
}

constexpr int PH_PER_LAYER = 17, N_PHASES = 2 + 2 * PH_PER_LAYER;
template <int ph> __device__ __forceinline__ void run_phase(const PR& p, unsigned char* shm) {
    unsigned char* ar = p.ws + OFF_ARENA; unsigned char* W = p.ws + OFF_WMIX;
    float* xc = (float*)(p.ws + OFF_XC);
    if (ph == 0) { ph_wconv_mix(p, shm, 0); ph_mod_partial(p, shm); return; }
    if (ph == 1) { ph_mod_reduce(p); return; }
    constexpr int l = (ph - 2) / PH_PER_LAYER, q = (ph - 2) % PH_PER_LAYER;
    const float* mod = (const float*)(p.ws + OFF_MOD) + (size_t)l * 5 * 6144;
    const float* xs_lat = (l == 0) ? p.in[I_X] : p.out; const float* xs_ctx = (l == 0) ? p.in[I_CTX] : xc;
    const int MM = (l == 1) ? NLAT : NTOK;
    switch (q) {
    case 0: if (l == 0) ph_rowwise(xs_lat, xs_ctx, nullptr, nullptr, nullptr, nullptr, 0, p.in[I_NMPRE] + l * DM, 0, 1, (bf16_t*)p.out, mod, mod, NTOK, nullptr, (bf16_t*)xc); break;
    case 1: if (l == 0) {
                run_gemm<E_STORE>(shm, (const bf16_t*)p.out, 1024, (const bf16_t*)(W + W_WIN), 1024, NLAT, LDP, 1024, mk_epi<E_STORE>((bf16_t*)(ar + A_P), LDP));
                run_gemm<E_STORE>(shm, (const bf16_t*)xc, 1024, (const bf16_t*)(W + W_WIN), 1024, NCTX, LDP, 1024, mk_epi<E_STORE>((bf16_t*)(ar + A_P) + (size_t)NLAT * LDP, LDP), 128);
            } else run_gemm<E_STORE>(shm, (const bf16_t*)(ar + A_H), 1024, (const bf16_t*)(W + W_WIN), 1024, NTOK, LDP, 1024, mk_epi<E_STORE>((bf16_t*)(ar + A_P), LDP));
            break;
    case 2: ph_gla_a(p, shm, l); break;
    case 3: ph_gla_b(p); break;
    case 4: ph_gla_c(p, shm, l); break;
    case 5: ph_rw_prep(p, l); break;
    case 6: if (l >= 1) run_gemm<E_STORE>(shm, (const bf16_t*)(ar + A_RKVS) + 1024, 1536, (const bf16_t*)(W + W_VD), 512, NTOK, 256, 512, mk_epi<E_STORE>((bf16_t*)(ar + A_VDB), 256)); break;
    case 7: if (l >= 1) run_gemm<E_VRES>(shm, (const bf16_t*)(ar + A_VDB), 256, (const bf16_t*)(W + W_VU), 256, NTOK, 512, 256,
                                         mk_epi<E_VRES>((bf16_t*)(ar + A_RKVS) + 1024, 1536, (const bf16_t*)(p.ws + OFF_VF), 512, p.in[I_VB] + (size_t)(l - 1) * 512)); break;
    case 8: run_gemm<E_LR>(shm, (const bf16_t*)(ar + A_AS), 384, (const bf16_t*)(W + W_BD), 384, NTOK, 2560, 384, mk_epi<E_LR>((bf16_t*)(ar + A_LR), 2048, (const bf16_t*)(ar + A_G), 512, p.in[I_W0] + (size_t)l * 1024, p.in[I_A0] + (size_t)l * 1024)); break;
    case 9: ph_rw_scan(p, shm, l); break;
    case 10: ph_rw_post(p, l, MM);
             if (l != 0) ph_rowwise(xs_lat, xs_ctx, nullptr, nullptr, nullptr, nullptr, 0, p.in[I_NMPRE] + l * DM, 0, 1, (bf16_t*)(ar + A_HR), mod, mod, MM); break;
    case 11: {
        bf16_t* G1 = (bf16_t*)(ar + A_G1); bf16_t* G2 = (bf16_t*)(ar + A_G2);
        const bf16_t* H = (l == 0) ? (const bf16_t*)p.out : (const bf16_t*)(ar + A_HR);
        run_gemm<E_SIGMOID>(shm, H, 1024, (const bf16_t*)(W + W_GRW), 1024, NLAT, 1024, 1024, mk_epi<E_SIGMOID>(G1, 1024));
        run_gemm<E_MUL>(shm, (const bf16_t*)(ar + A_YF), 512, (const bf16_t*)(W + W_RWO), 512, NLAT, 1024, 512, mk_epi<E_MUL>(G1, 1024));
        run_gemm<E_SIGMOID>(shm, H, 1024, (const bf16_t*)(W + W_GGLA), 1024, NLAT, 1024, 1024, mk_epi<E_SIGMOID>(G2, 1024));
        run_gemm<E_FMA>(shm, (const bf16_t*)(ar + A_YG), 512, (const bf16_t*)(W + W_GLO), 512, NLAT, 1024, 512, mk_epi<E_FMA>(G1, 1024, G2, 1024));
        if (l == 0) {
            const size_t ro = (size_t)NLAT; const bf16_t* Hc = (const bf16_t*)xc;
            run_gemm<E_SIGMOID>(shm, Hc, 1024, (const bf16_t*)(W + W_GRW), 1024, NCTX, 1024, 1024, mk_epi<E_SIGMOID>(G1 + ro * 1024, 1024), 64);
            run_gemm<E_MUL>(shm, (const bf16_t*)(ar + A_YF) + ro * 512, 512, (const bf16_t*)(W + W_RWO), 512, NCTX, 1024, 512, mk_epi<E_MUL>(G1 + ro * 1024, 1024), 64);
            run_gemm<E_SIGMOID>(shm, Hc, 1024, (const bf16_t*)(W + W_GGLA), 1024, NCTX, 1024, 1024, mk_epi<E_SIGMOID>(G2 + ro * 1024, 1024), 64);
            run_gemm<E_FMA>(shm, (const bf16_t*)(ar + A_YG) + ro * 512, 512, (const bf16_t*)(W + W_GLO), 512, NCTX, 1024, 512, mk_epi<E_FMA>(G1 + ro * 1024, 1024, G2 + ro * 1024, 1024), 64);
        }
    } break;
    case 12: run_gemm<E_STORE>(shm, (const bf16_t*)(ar + A_G1), 1024, (const bf16_t*)(W + W_MRG), 1024, NLAT, 1024, 1024, mk_epi<E_STORE>((bf16_t*)(ar + A_M), 1024));
             if (l == 0) {
#pragma unroll
                 for (int sl = 0; sl < 4; ++sl) run_gemm<E_F32>(shm, (const bf16_t*)(ar + A_G1) + (size_t)NLAT * 1024 + sl * 256, 1024, (const bf16_t*)(W + W_MRG) + sl * 256, 1024, NCTX, 1024, 256,
                                                                 mk_epi<E_F32>((bf16_t*)((float*)(ar + A_PART12) + (size_t)sl * NCTX * DM), 1024), 16 * sl + 64); }
             break;
    case 13: ph_rowwise(xs_lat, xs_ctx, p.out, xc, (const bf16_t*)(ar + A_M), p.in[I_NMPOST] + l * DM, 2, p.in[I_NFPRE] + l * DM, 3, 4, (bf16_t*)(ar + A_H2), mod, mod, MM, (const float*)(ar + A_PART12));
             ph_wconv_mlp(p, shm, l); break;
    case 14: run_gemm<E_RELU2>(shm, (const bf16_t*)(ar + A_H2), 1024, (const bf16_t*)(ar + A_WMLP), 1024, MM, 4096, 1024, mk_epi<E_RELU2>((bf16_t*)(ar + A_U), 4096)); break;
    case 15: run_gemm<E_STORE>(shm, (const bf16_t*)(ar + A_U), 4096, (const bf16_t*)(ar + A_WMLP) + (size_t)DFF * DM, 4096, NLAT, 1024, 4096, mk_epi<E_STORE>((bf16_t*)(ar + A_F), 1024));
             if (l == 0) {
#pragma unroll
                 for (int sl = 0; sl < 4; ++sl) run_gemm<E_F32>(shm, (const bf16_t*)(ar + A_U) + (size_t)NLAT * 4096 + sl * 1024, 4096, (const bf16_t*)(ar + A_WMLP) + (size_t)DFF * DM + sl * 1024, 4096, NCTX, 1024, 1024,
                                                                 mk_epi<E_F32>((bf16_t*)((float*)(ar + A_PART15) + (size_t)sl * NCTX * DM), 1024), 16 * sl + 64); }
             break;
    case 16:
        if (l == 0) { const float* mod1 = (const float*)(p.ws + OFF_MOD) + (size_t)5 * 6144;
            ph_rowwise(p.out, xc, p.out, xc, (const bf16_t*)(ar + A_F), p.in[I_NFPOST] + l * DM, 5, p.in[I_NMPRE] + (l + 1) * DM, 0, 1, (bf16_t*)(ar + A_H), mod, mod1, NTOK, (const float*)(ar + A_PART15));
            ph_wconv_mix(p, shm, 1); }
        else ph_rowwise(p.out, xc, p.out, xc, (const bf16_t*)(ar + A_F), p.in[I_NFPOST] + l * DM, 5, nullptr, 0, 0, nullptr, mod, mod, NLAT);
        break;
    }
}

constexpr bool phase_empty(int ph) { return ph >= 2 && ((((ph - 2) / PH_PER_LAYER) == 0 && (((ph - 2) % PH_PER_LAYER) == 6 || ((ph - 2) % PH_PER_LAYER) == 7)) || (((ph - 2) / PH_PER_LAYER) == 1 && ((ph - 2) % PH_PER_LAYER) == 0)); }
template <int ph> __device__ __forceinline__ void phase_seq(const PR& p, unsigned char* shm, int lo, int hi, int coop, const XcdBarrier& xb) {
    if constexpr (ph < N_PHASES) {
        if constexpr (!phase_empty(ph)) {
            if (lo <= ph && ph < hi) {
                run_phase<ph>(p, shm);
                if constexpr (ph >= 2 && ph < 2 + PH_PER_LAYER && ((DBG_REP >> (ph - 2)) & 1)) { if (coop) xcd_barrier(xb); run_phase<ph>(p, shm); }
                if (coop && ph + 1 < hi) xcd_barrier(xb);
            }
        }
        phase_seq<ph + 1>(p, shm, lo, hi, coop, xb);
    }
}
__global__ void __launch_bounds__(NTHREADS, 2) k_mega(PR p, int ph_lo, int ph_hi, int coop) {
    extern __shared__ __attribute__((aligned(16))) unsigned char shm[];
    XcdBarrier xb; xb.bar = nullptr; xb.x = 0; xb.st = (volatile LAS unsigned*)(shm + LDS_BYTES - 16);
    if (coop) {
        if (coop > 1) cg::this_grid().sync();
        if (threadIdx.x == 0) { xb.st[0] = 0u; xb.st[1] = 0u; }
        __syncthreads();
        xb = xcd_barrier_post((unsigned*)(p.ws + OFF_BAR), (volatile LAS unsigned*)(shm + LDS_BYTES - 16));
    }
    phase_seq<0>(p, shm, ph_lo, ph_hi, coop, xb);
}

#if DBG_HI
__global__ void k_dump(PR p, size_t off, int nelem) {
    const bf16_t* src = (const bf16_t*)(p.ws + off);
    for (int i = blockIdx.x * blockDim.x + threadIdx.x; i < NLAT * DM; i += gridDim.x * blockDim.x) p.out[i] = (i < nelem) ? bf2f(src[i]) : 0.f;
}
#endif
extern "C" void kernel_launch(void* const* d_in, const int* in_sizes, int n_in, void* d_out, int out_size, void* d_ws, size_t ws_size, hipStream_t stream) {
    static int grid = 0;
    if (grid == 0) {
        if (n_in != N_IN || ws_size < WS_NEED) { fprintf(stderr, "kernel_launch: unexpected inputs (%d) or workspace (%zu < %zu)\n", n_in, ws_size, (size_t)WS_NEED); grid = -1; return; }
        int dev = 0, cus = 0, per_cu = 0;
        hipGetDevice(&dev); hipDeviceGetAttribute(&cus, hipDeviceAttributeMultiprocessorCount, dev);
        hipFuncSetAttribute((const void*)k_mega, hipFuncAttributeMaxDynamicSharedMemorySize, LDS_BYTES);
        hipOccupancyMaxActiveBlocksPerMultiprocessor(&per_cu, (const void*)k_mega, NTHREADS, LDS_BYTES);
        (void)hipGetLastError();
        if (per_cu < 1) per_cu = 1;
        grid = cus * 1;
        if (grid > 256) grid = 256;
    }
    if (grid < 0) return;
    PR p{};
    for (int i = 0; i < N_IN; ++i) p.in[i] = (const float*)d_in[i];
    p.out = (float*)d_out; p.ws = (unsigned char*)d_ws;
#if MEGA
    if (hipMemsetAsync((char*)d_ws + OFF_BAR, 0, XCD_BAR_WORDS * 4, stream) != hipSuccess) { fprintf(stderr, "kernel_launch: memset of the barrier words failed\n"); return; }
    int lo = 0, hi = N_PHASES, coop = 1;
    void* args[] = {&p, &lo, &hi, &coop};
    hipError_t e = hipLaunchCooperativeKernel((const void*)k_mega, dim3(grid), dim3(NTHREADS), args, LDS_BYTES, stream);
    if (e != hipSuccess) fprintf(stderr, "cooperative launch failed: %s (grid %d)\n", hipGetErrorString(e), grid);
#else
    for (int ph = 0; ph < (DBG_HI ? DBG_HI : N_PHASES); ++ph) {
        const int l = (ph - 2) / PH_PER_LAYER, q = (ph - 2) % PH_PER_LAYER;
        if (ph >= 2 && ((l == 0 && (q == 6 || q == 7)) || (l == 1 && q == 0))) continue;
        hipLaunchKernelGGL(k_mega, dim3(grid), dim3(NTHREADS), LDS_BYTES, stream, p, ph, ph + 1, 0);
    }
#if DBG_HI
#ifdef DBG_OFF
    hipLaunchKernelGGL(k_dump, dim3(1024), dim3(256), 0, stream, p, (size_t)(DBG_OFF), (int)(DBG_N));
#endif
#endif
#endif
}
```
